# Optimizing an MI355X kernel written in HIP

```python
import math
import jax, jax.numpy as jnp
from jax import lax
import numpy as np

D_MODEL = 1024
BATCH = 32
SEQ = 2048
DEPTH = 2
DEC_BATCH = 8
DEC_SEQ = 16
PAST_LEN = 1024

CHUNK = 64
HEAD_DIM = 64
SB_HEADS = 6
SB_WIDTH = SB_HEADS * HEAD_DIM
SB_BLOCK = 128
MLP_GROUPS = 4
MLP_WIDTH = MLP_GROUPS * HEAD_DIM
MLP_CHUNK = 128
HG_HEADS = 6
HG_KDIM = 64
HG_VDIM = 64
HG_WIDTH = HG_HEADS * HG_VDIM
HG_BLOCK = CHUNK
MIX_WIDTH = SB_WIDTH + MLP_WIDTH + HG_WIDTH
IN_WIDTH = 3 * SB_WIDTH + 2 * MLP_WIDTH + 2 * HG_HEADS * HG_KDIM + 2 * HG_WIDTH
D_FF = 4 * D_MODEL
ALPHA = (2 * DEPTH) ** 0.25
BETA_INIT = (8 * DEPTH) ** -0.25
LN_EPS = 1e-5
RMS_EPS = 1e-6

kernel_name = 'hybrid_stickbreak_gmlp_hgrn2_stream_step'


def layer_norm(x, g, b):
    xf = x.astype(jnp.float32)
    mu = jnp.mean(xf, axis=-1, keepdims=True)
    var = jnp.mean(jnp.square(xf - mu), axis=-1, keepdims=True)
    return ((xf - mu) * lax.rsqrt(var + LN_EPS) * g + b).astype(x.dtype)


def split_proj(p):
    sizes = (SB_WIDTH,) * 3 + (MLP_WIDTH,) * 2 + (HG_HEADS * HG_KDIM,) * 2 + (HG_WIDTH,) * 2
    out, off = [], 0
    for s in sizes:
        out.append(p[..., off:off + s])
        off += s
    return out


def stick_breaking(q, k, v, q_start):
    Lq, Lk = q.shape[1], k.shape[1]
    z = jnp.einsum('bqhd,bkhd->bhqk', q, k).astype(jnp.float32) / math.sqrt(HEAD_DIM)
    t_pos = q_start + jnp.arange(Lq)
    s_pos = jnp.arange(Lk)
    mask = s_pos[None, :] < t_pos[:, None]
    log_beta = jax.nn.log_sigmoid(z)
    log_keep = jnp.where(mask, jax.nn.log_sigmoid(-z), 0.0)
    later = lax.cumsum(log_keep, axis=3, reverse=True) - log_keep
    w = jnp.where(mask, jnp.exp(log_beta + later), 0.0)
    return jnp.einsum('bhqk,bkhd->bqhd', w.astype(v.dtype), v)


def stick_breaking_prompt(q, k, v):
    L = q.shape[1]
    outs = []
    for i in range(L // SB_BLOCK):
        lo, hi = i * SB_BLOCK, (i + 1) * SB_BLOCK
        outs.append(stick_breaking(q[:, lo:hi], k[:, :hi], v[:, :hi], lo))
    return jnp.concatenate(outs, axis=1)


def spatial_gate(u, v, ln_g, ln_b, w_s, b_s):
    B, L, _ = u.shape
    vn = layer_norm(v, ln_g, ln_b)
    nc = max(L // MLP_CHUNK, 1)
    cl = L // nc
    tri = jnp.tril(jnp.ones((cl, cl), dtype=bool))
    w = jnp.where(tri[None], w_s[:, :cl, :cl], 0.0)
    vc = vn.reshape(B, nc, cl, MLP_GROUPS, HEAD_DIM)
    mixed = jnp.einsum('gts,bcsgd->bctgd', w, vc) + jnp.transpose(b_s[:, :cl])[None, None, :, :, None]
    return u * mixed.reshape(B, L, MLP_WIDTH).astype(u.dtype), vn


def hgrn_lower_bounds(logits):
    g = jax.nn.softmax(logits.astype(jnp.float32), axis=0)
    c = jnp.cumsum(g, axis=0)
    return c - c[0:1]


def hgrn2_inputs(h_q, h_f, h_i, lb):
    B, L, _ = h_q.shape
    zf = h_f.astype(jnp.float32)
    log_f = jnp.logaddexp(jnp.log(lb), jnp.log1p(-lb) + jax.nn.log_sigmoid(zf))
    k = (1.0 - lb) * jax.nn.sigmoid(-zf)
    q = jax.nn.silu(h_q.astype(jnp.float32))
    v = h_i.astype(jnp.float32)
    heads = lambda a: a.reshape(B, L, HG_HEADS, -1).transpose(0, 2, 1, 3)
    return heads(q), heads(k), heads(v), heads(log_f)


def hgrn2_block(S, q, k, v, log_f):
    S = S.astype(jnp.float32)
    T = q.shape[2]
    b = jnp.cumsum(log_f, axis=2)
    causal = jnp.tril(jnp.ones((T, T), dtype=bool))
    rel = jnp.where(causal[None, None, :, :, None], b[:, :, :, None, :] - b[:, :, None, :, :], -jnp.inf)
    scores = jnp.einsum('bhtd,bhsd,bhtsd->bhts', q, k, jnp.exp(rel))
    o = jnp.einsum('bhts,bhse->bhte', scores, v) + jnp.einsum('bhtd,bhde->bhte', q * jnp.exp(b), S)
    b_last = b[:, :, -1:, :]
    S_new = jnp.exp(b_last[:, :, 0, :])[..., None] * S + jnp.einsum('bhsd,bhse->bhde', k * jnp.exp(b_last - b), v)
    return S_new, o


def hgrn2_prompt(q, k, v, log_f):
    B, H, L, _ = q.shape
    n = L // HG_BLOCK
    split = lambda a: jnp.moveaxis(a.reshape(B, H, n, HG_BLOCK, a.shape[-1]), 2, 0)
    S0 = jnp.zeros((B, H, HG_KDIM, HG_VDIM), jnp.float32)
    S, o = lax.scan(lambda s, xs: hgrn2_block(s, *xs), S0, (split(q), split(k), split(v), split(log_f)))
    return S, jnp.moveaxis(o, 0, 2).reshape(B, H, L, HG_VDIM)


def trunk(x, past_k, past_v, hg_state, w_in, w_out, mlp_ln_g, mlp_ln_b, mlp_ws, mlp_bs,
          hg_lb_logits, hg_norm_w, ln1_g, ln1_b, w_ff1, w_ff2, ln2_g, ln2_b):
    B, L, _ = x.shape
    prompt = past_k is None
    lbs = hgrn_lower_bounds(hg_lb_logits)
    new_k, new_v, new_s, new_mv = [], [], [], []
    for l in range(DEPTH):
        q_a, k_a, v_a, u_b, v_b, q_c, f_c, i_c, g_c = split_proj(x @ w_in[l])
        qa = q_a.reshape(B, L, SB_HEADS, HEAD_DIM)
        ka = k_a.reshape(B, L, SB_HEADS, HEAD_DIM)
        va = v_a.reshape(B, L, SB_HEADS, HEAD_DIM)
        if prompt:
            o_a = stick_breaking_prompt(qa, ka, va)
        else:
            o_a = stick_breaking(qa, jnp.concatenate([past_k[l].astype(ka.dtype), ka], axis=1),
                                 jnp.concatenate([past_v[l].astype(va.dtype), va], axis=1), past_k.shape[2])
        o_b, vn = spatial_gate(u_b, v_b, mlp_ln_g[l], mlp_ln_b[l], mlp_ws[l], mlp_bs[l])
        hq, hk, hv, hf = hgrn2_inputs(q_c, f_c, i_c, lbs[l])
        if prompt:
            S, o = hgrn2_prompt(hq, hk, hv, hf)
        else:
            S, o = hgrn2_block(hg_state[l], hq, hk, hv, hf)
        o = o.transpose(0, 2, 1, 3)
        o = o * lax.rsqrt(jnp.mean(o * o, axis=-1, keepdims=True) + RMS_EPS) * hg_norm_w[l].reshape(HG_HEADS, HG_VDIM)
        o_c = (o.reshape(B, L, HG_WIDTH) * jax.nn.sigmoid(g_c.astype(jnp.float32))).astype(x.dtype)
        mix = jnp.concatenate([o_a.reshape(B, L, SB_WIDTH).astype(x.dtype), o_b.astype(x.dtype), o_c], axis=-1)
        x = layer_norm(ALPHA * x + mix @ w_out[l], ln1_g[l], ln1_b[l])
        hdn = jnp.square(jax.nn.relu(x @ w_ff1[l]))
        x = layer_norm(ALPHA * x + hdn @ w_ff2[l], ln2_g[l], ln2_b[l])
        new_k.append(ka)
        new_v.append(va)
        new_s.append(S)
        new_mv.append(vn)
    mv = None if prompt else jnp.stack(new_mv)
    return x, jnp.stack(new_k), jnp.stack(new_v), jnp.stack(new_s), mv


def setup_inputs(seed: int = 0) -> dict:
    key = jax.random.key(seed)
    ks = jax.random.split(key, 20)
    nrm = lambda k, s, sc: jax.random.normal(k, s, jnp.float32) * sc
    return {
        'x_prompt': nrm(ks[0], (BATCH, SEQ, D_MODEL), 1.0),
        'x_sample': nrm(ks[1], (DEC_BATCH, DEC_SEQ, D_MODEL), 1.0),
        'cache_sb_k': nrm(ks[2], (DEPTH, DEC_BATCH, PAST_LEN, SB_HEADS, HEAD_DIM), 1.0),
        'cache_sb_v': nrm(ks[3], (DEPTH, DEC_BATCH, PAST_LEN, SB_HEADS, HEAD_DIM), 1.0),
        'state_hgrn': nrm(ks[4], (DEPTH, DEC_BATCH, HG_HEADS, HG_KDIM, HG_VDIM), 0.5),
        'w_in': nrm(ks[5], (DEPTH, D_MODEL, IN_WIDTH), D_MODEL ** -0.5),
        'w_out': nrm(ks[6], (DEPTH, MIX_WIDTH, D_MODEL), MIX_WIDTH ** -0.5 * BETA_INIT),
        'mlp_ln_g': 1.0 + nrm(ks[7], (DEPTH, MLP_WIDTH), 0.05),
        'mlp_ln_b': nrm(ks[8], (DEPTH, MLP_WIDTH), 0.02),
        'mlp_ws': nrm(ks[9], (DEPTH, MLP_GROUPS, MLP_CHUNK, MLP_CHUNK), MLP_CHUNK ** -0.5),
        'mlp_bs': 1.0 + nrm(ks[10], (DEPTH, MLP_GROUPS, MLP_CHUNK), 0.1),
        'hg_lb_logits': nrm(ks[11], (DEPTH, HG_HEADS * HG_KDIM), 0.5),
        'hg_norm_w': 1.0 + nrm(ks[12], (DEPTH, HG_WIDTH), 0.05),
        'ln1_g': 1.0 + nrm(ks[13], (DEPTH, D_MODEL), 0.05),
        'ln1_b': nrm(ks[14], (DEPTH, D_MODEL), 0.02),
        'w_ff1': nrm(ks[15], (DEPTH, D_MODEL, D_FF), D_MODEL ** -0.5),
        'w_ff2': nrm(ks[16], (DEPTH, D_FF, D_MODEL), D_FF ** -0.5 * BETA_INIT),
        'ln2_g': 1.0 + nrm(ks[17], (DEPTH, D_MODEL), 0.05),
        'ln2_b': nrm(ks[18], (DEPTH, D_MODEL), 0.02),
    }


def reference(x_prompt, x_sample, cache_sb_k, cache_sb_v, state_hgrn, w_in, w_out, mlp_ln_g, mlp_ln_b,
              mlp_ws, mlp_bs, hg_lb_logits, hg_norm_w, ln1_g, ln1_b, w_ff1, w_ff2, ln2_g, ln2_b):
    y_prompt, new_sb_k_prompt, new_sb_v_prompt, new_hgrn_prompt, _unused = trunk(
        x_prompt, None, None, None, w_in, w_out, mlp_ln_g, mlp_ln_b, mlp_ws, mlp_bs,
        hg_lb_logits, hg_norm_w, ln1_g, ln1_b, w_ff1, w_ff2, ln2_g, ln2_b)
    y_sample, new_sb_k_sample, new_sb_v_sample, new_hgrn_sample, new_mlp_v_sample = trunk(
        x_sample, cache_sb_k, cache_sb_v, state_hgrn, w_in, w_out, mlp_ln_g, mlp_ln_b, mlp_ws, mlp_bs,
        hg_lb_logits, hg_norm_w, ln1_g, ln1_b, w_ff1, w_ff2, ln2_g, ln2_b)
    return (y_prompt, y_sample, new_sb_k_prompt, new_sb_v_prompt, new_hgrn_prompt,
            new_sb_k_sample, new_sb_v_sample, new_hgrn_sample, new_mlp_v_sample)
```

```cpp
#include <hip/hip_runtime.h>
#include <hip/hip_cooperative_groups.h>
#include <cstdio>
#include <cstdint>
namespace cg = cooperative_groups;
namespace pg8 {
#define PG8_LAS __attribute__((address_space(3)))
typedef unsigned short bf16_t;
typedef short bf16x8 __attribute__((ext_vector_type(8)));
typedef float f32x4 __attribute__((ext_vector_type(4)));
typedef unsigned u32x4 __attribute__((ext_vector_type(4)));
constexpr int BM = 256, BK = 64, HALF = 128, HTB = HALF * BK * 2  , STAGE_BYTES = 8 * HTB, NXCD = 8, WGM = 8;

__host__ __device__ __forceinline__ int lds_byte(int r, int c) { const int st = (r >> 4) * 2 + (c >> 5), rr = r & 15, cc = c & 31, ob = rr * 64 + cc * 2; return st * 1024 + (ob ^ (((ob >> 9) & 1) << 5)); }
__host__ __device__ __forceinline__ void stage_rc(int b, int& R, int& C) { const int st = b / 1024, sb = b % 1024, swz = sb ^ (((sb >> 9) & 1) << 5); R = (st >> 1) * 16 + swz / 64; C = (st & 1) * 32 + (swz % 64) / 2; }
__host__ __device__ __forceinline__ int perm32(int rho) { const int n = rho >> 4, i = rho & 15; return 8 * (i >> 2) + 4 * n + (i & 3); }

struct Unit { int pm, pn; };
struct Gemm { const bf16_t* A; const bf16_t* Bt; int M, N, K; };

struct StaticOrder {
    int nM, nN, nwg, G, c;
    __host__ __device__ void init(int M, int N, int G_, int c_) { nM = M / BM; nN = N / BM; nwg = nM * nN; G = G_; c = c_; }
    __host__ __device__ bool next(int i, Unit& u) const {
        const long L = (long)i * G + c; if (L >= nwg) return false;
        int wgid = (int)L; { const int q = nwg / NXCD, r = nwg % NXCD, xcd = wgid % NXCD, off = wgid / NXCD; wgid = (xcd < r ? xcd * (q + 1) : r * (q + 1) + (xcd - r) * q) + off; }
        const int nig = WGM * nN, gid = wgid / nig, fm = gid * WGM, gsz = (nM - fm) < WGM ? (nM - fm) : WGM;
        u.pm = fm + ((wgid % nig) % gsz); u.pn = (wgid % nig) / gsz; return true;
    }
    __device__ __forceinline__ void a_ready(const Unit&) const {}
    __device__ __forceinline__ void done(const Unit&) const {}
};

template <class Epi, class Sched, bool ALIGN_EPI = false, bool SP2 = false>
__device__ __forceinline__ void gemm_phase(PG8_LAS unsigned char* lds, const Gemm g, const Sched& S, const Epi& E) {
    int tid_l = threadIdx.x; asm volatile("" : "+v"(tid_l)); const int tid = tid_l, wid = __builtin_amdgcn_readfirstlane(tid >> 6), lane = tid & 63, wr = wid >> 2, wc = wid & 3, fr = lane & 15, fq = lane >> 4;
    const int K = g.K, nt = K / BK;
    unsigned voffA[2], voffB[2];
#pragma unroll
    for (int i = 0; i < 2; ++i) { int R, C; stage_rc(tid * 16 + i * 8192, R, C); const int Rb = Epi::PERM ? ((R & ~31) + perm32(R & 31)) : R;
        voffA[i] = (unsigned)(R * K + C) * 2u; voffB[i] = (unsigned)(Rb * K + C) * 2u; }
    const size_t kstep = (size_t)(BK * 2);
    const size_t hstep = (size_t)HALF * K * 2;
    const size_t tstep = 2 * hstep;
    const unsigned ldsw = (unsigned)wid * 1024u;
    const int aoff = lds_byte(wr * 64 + fr, fq * 8), boff = lds_byte(wc * 32 + fr, fq * 8);
#define PG8_SA(b, h) (((b) * 2 + (h)) * HTB)
#define PG8_SB(b, h) ((4 + (b) * 2 + (h)) * HTB)
#define PG8_STAGE(bufoff, gbase, voff) do { _Pragma("unroll") for (int _i = 0; _i < 2; ++_i) \
        __builtin_amdgcn_global_load_lds((const unsigned*)((const char*)(gbase) + (voff)[_i]), (PG8_LAS unsigned*)(lds + (bufoff) + ldsw + _i * 8192), 16, 0, 0); } while (0)
#define PG8_LDA(dst, b, h) do { _Pragma("unroll") for (int m = 0; m < 4; ++m) _Pragma("unroll") for (int k = 0; k < 2; ++k) dst[m][k] = *(const PG8_LAS bf16x8*)(lds + PG8_SA(b, h) + aoff + m * 2048 + k * 1024); } while (0)
#define PG8_LDB(dst, b, h) do { _Pragma("unroll") for (int n = 0; n < 2; ++n) _Pragma("unroll") for (int k = 0; k < 2; ++k) dst[n][k] = *(const PG8_LAS bf16x8*)(lds + PG8_SB(b, h) + boff + n * 2048 + k * 1024); } while (0)
#define PG8_MMA(ai, bj, At, Bt) do { __builtin_amdgcn_s_setprio(1); _Pragma("unroll") for (int m = 0; m < 4; ++m) _Pragma("unroll") for (int n = 0; n < 2; ++n) _Pragma("unroll") for (int k = 0; k < 2; ++k) \
        acc[ai][bj][m][n] = __builtin_amdgcn_mfma_f32_16x16x32_bf16(Bt[n][k], At[m][k], acc[ai][bj][m][n], 0, 0, 0); __builtin_amdgcn_s_setprio(0); } while (0)
#define PG8_WAIT_V(n) asm volatile("s_waitcnt vmcnt(" #n ")" ::: "memory")
#define PG8_WAIT_L(n) asm volatile("s_waitcnt lgkmcnt(" #n ")" ::: "memory")
#define PG8_BAR __builtin_amdgcn_s_barrier()
#define PG8_SCHED __builtin_amdgcn_sched_barrier(0)
    Unit cur, nxt; int ui = 0;
    if (!S.next(0, cur)) return;
    f32x4 acc[2][2][4][2];
#pragma unroll
    for (int a = 0; a < 2; ++a)
#pragma unroll
        for (int b = 0; b < 2; ++b)
#pragma unroll
            for (int m = 0; m < 4; ++m)
#pragma unroll
                for (int n = 0; n < 2; ++n) acc[a][b][m][n] = (f32x4){0.f, 0.f, 0.f, 0.f};
    bf16x8 At[4][2], B0[2][2], B1[2][2];
    const char* cA = (const char*)g.A + (size_t)cur.pm * tstep; const char* cB = (const char*)g.Bt + (size_t)cur.pn * tstep;
    S.a_ready(cur);
    if constexpr (SP2) {
        PG8_STAGE(PG8_SB(0, 0), cB, voffB); PG8_STAGE(PG8_SB(0, 1), cB + hstep, voffB); PG8_STAGE(PG8_SA(0, 0), cA, voffA); PG8_STAGE(PG8_SA(0, 1), cA + hstep, voffA);
        if (wr == 1) PG8_BAR;
        PG8_WAIT_V(2); PG8_BAR;
        PG8_STAGE(PG8_SB(1, 0), cB + kstep, voffB); PG8_STAGE(PG8_SA(1, 0), cA + kstep, voffA); PG8_STAGE(PG8_SB(1, 1), cB + hstep + kstep, voffB);
        PG8_WAIT_V(6); PG8_BAR;
    } else {
        PG8_STAGE(PG8_SB(0, 0), cB, voffB); PG8_STAGE(PG8_SA(0, 0), cA, voffA); PG8_STAGE(PG8_SB(0, 1), cB + hstep, voffB); PG8_STAGE(PG8_SA(0, 1), cA + hstep, voffA);
        if (wr == 1) PG8_BAR;
        PG8_WAIT_V(4); PG8_BAR;
        PG8_STAGE(PG8_SB(1, 0), cB + kstep, voffB); PG8_STAGE(PG8_SA(1, 0), cA + kstep, voffA); PG8_STAGE(PG8_SB(1, 1), cB + hstep + kstep, voffB);
        PG8_WAIT_V(6); PG8_BAR;
    }
    for (;;) {
        const bool has_next = S.next(ui + 1, nxt);
        const char* nA = has_next ? (const char*)g.A + (size_t)nxt.pm * tstep : cA; const char* nB = has_next ? (const char*)g.Bt + (size_t)nxt.pn * tstep : cB;
        for (int t = 0; t < nt; t += 2) {
            const bool last = (t == nt - 2);
            const char* a1 = cA + (size_t)(t + 1) * kstep;
            const char* a2 = last ? nA : cA + (size_t)(t + 2) * kstep; const char* b2 = last ? nB : cB + (size_t)(t + 2) * kstep;
            const char* a3 = a2 + kstep; const char* b3 = b2 + kstep;
            if (last && has_next) S.a_ready(nxt);
            if constexpr (SP2) {
            PG8_LDB(B0, 0, 0); PG8_LDB(B1, 0, 1); PG8_SCHED; PG8_LDA(At, 0, 0); PG8_STAGE(PG8_SA(1, 1), a1 + hstep, voffA);
            PG8_WAIT_V(8); PG8_WAIT_L(0); PG8_BAR; PG8_MMA(0, 0, At, B0); PG8_MMA(0, 1, At, B1); PG8_BAR; PG8_SCHED;
            PG8_LDA(At, 0, 1); PG8_STAGE(PG8_SB(0, 0), b2, voffB); PG8_STAGE(PG8_SB(0, 1), b2 + hstep, voffB); PG8_STAGE(PG8_SA(0, 0), a2, voffA);
            PG8_WAIT_V(8); PG8_WAIT_L(0); PG8_BAR; PG8_MMA(1, 0, At, B0); PG8_MMA(1, 1, At, B1); PG8_BAR; PG8_SCHED;
            PG8_LDB(B0, 1, 0); PG8_LDB(B1, 1, 1); PG8_SCHED; PG8_LDA(At, 1, 0); PG8_STAGE(PG8_SA(0, 1), a2 + hstep, voffA);
            PG8_WAIT_V(8); PG8_WAIT_L(0); PG8_BAR; PG8_MMA(0, 0, At, B0); PG8_MMA(0, 1, At, B1); PG8_BAR; PG8_SCHED;
            PG8_LDA(At, 1, 1); PG8_STAGE(PG8_SB(1, 0), b3, voffB); PG8_STAGE(PG8_SB(1, 1), b3 + hstep, voffB); PG8_STAGE(PG8_SA(1, 0), a3, voffA);
            PG8_WAIT_V(8); PG8_WAIT_L(0); PG8_BAR; PG8_MMA(1, 0, At, B0); PG8_MMA(1, 1, At, B1); PG8_BAR; PG8_SCHED;
            } else {
            PG8_LDB(B0, 0, 0); PG8_SCHED; PG8_LDA(At, 0, 0); PG8_STAGE(PG8_SA(1, 1), a1 + hstep, voffA);
            PG8_WAIT_L(8); PG8_BAR; PG8_WAIT_L(0); PG8_MMA(0, 0, At, B0); PG8_BAR; PG8_SCHED;
            PG8_LDB(B1, 0, 1); PG8_STAGE(PG8_SB(0, 0), b2, voffB);
            PG8_BAR; PG8_WAIT_L(0); PG8_MMA(0, 1, At, B1); PG8_BAR;
            PG8_LDA(At, 0, 1); PG8_STAGE(PG8_SA(0, 0), a2, voffA);
            PG8_BAR; PG8_WAIT_L(0); PG8_MMA(1, 0, At, B0); PG8_BAR; PG8_SCHED;
            PG8_STAGE(PG8_SB(0, 1), b2 + hstep, voffB);
            PG8_WAIT_V(6); PG8_BAR; PG8_MMA(1, 1, At, B1); PG8_BAR;
            PG8_LDB(B0, 1, 0); PG8_SCHED; PG8_LDA(At, 1, 0); PG8_STAGE(PG8_SA(0, 1), a2 + hstep, voffA);
            PG8_WAIT_L(8); PG8_BAR; PG8_WAIT_L(0); PG8_MMA(0, 0, At, B0); PG8_BAR; PG8_SCHED;
            PG8_LDB(B1, 1, 1); PG8_STAGE(PG8_SB(1, 0), b3, voffB);
            PG8_BAR; PG8_WAIT_L(0); PG8_MMA(0, 1, At, B1); PG8_BAR;
            PG8_LDA(At, 1, 1); PG8_STAGE(PG8_SA(1, 0), a3, voffA);
            PG8_BAR; PG8_WAIT_L(0); PG8_MMA(1, 0, At, B0); PG8_BAR; PG8_SCHED;
            PG8_STAGE(PG8_SB(1, 1), b3 + hstep, voffB);
            PG8_WAIT_V(6); PG8_BAR; PG8_MMA(1, 1, At, B1); PG8_BAR;
            }
        }
        if constexpr (ALIGN_EPI) { if (wr == 0) PG8_BAR; }
        if constexpr (!Epi::AFTER_DRAIN) { E(acc, cur, wr, wc, fr, fq); S.done(cur); }
        if (!has_next) break;
#pragma unroll
        for (int a = 0; a < 2; ++a)
#pragma unroll
            for (int b = 0; b < 2; ++b)
#pragma unroll
                for (int m = 0; m < 4; ++m)
#pragma unroll
                    for (int n = 0; n < 2; ++n) acc[a][b][m][n] = (f32x4){0.f, 0.f, 0.f, 0.f};
        cur = nxt; cA = nA; cB = nB; ++ui;
        if constexpr (ALIGN_EPI) { if (wr == 1) PG8_BAR; }
    }
    PG8_WAIT_V(0);
    if constexpr (!ALIGN_EPI) { if (wr == 0) PG8_BAR; }
    PG8_BAR;
    if constexpr (Epi::AFTER_DRAIN) { E.fused(acc, cur, wr, wc, fr, fq, lds, wid, lane); S.done(cur); }
#undef PG8_SA
#undef PG8_SB
#undef PG8_STAGE
#undef PG8_LDA
#undef PG8_LDB
#undef PG8_MMA
#undef PG8_WAIT_V
#undef PG8_WAIT_L
#undef PG8_BAR
#undef PG8_SCHED
}
}

using pg8::bf16_t; using pg8::bf16x8; using pg8::f32x4; using pg8::u32x4;
typedef float f32x16 __attribute__((ext_vector_type(16)));
typedef unsigned u32x2 __attribute__((ext_vector_type(2)));
#define LAS __attribute__((address_space(3)))
#define DI __device__ __forceinline__
#define MFMA32(a, b, c) __builtin_amdgcn_mfma_f32_32x32x16_bf16((a), (b), (c), 0, 0, 0)

constexpr int DM = 1024, MP = 65536, MS = 128, MT = MP + MS, SEQ = 2048, NBATCH = 32, DEPTH = 2;
constexpr int NIN = 3200, NINP = 3328, DFF = 4096, PP = NINP;
constexpr int C_Q = 0, C_K = 384, C_V = 768, C_U = 1152, C_VB = 1408, C_QC = 1664, C_FC = 2048, C_IC = 2432, C_GC = 2816;
constexpr float ALPHA = 1.41421356237309515f;
constexpr float QSCALE = 0.125f * 1.4426950408889634f;
constexpr int SKV = 1056;
constexpr int NTHR = 512, NWAVE = 8;

constexpr size_t MiB = 1u << 20;
constexpr size_t WS_CTL = 0, CTL_BYTES = 1 * MiB;
constexpr size_t WS_WIN = 2 * MiB, WIN_L = (size_t)NINP * DM * 2;
constexpr size_t WS_WOUT = 16 * MiB, WOUT_L = (size_t)DM * DM * 2;
constexpr size_t WS_WFF1 = 20 * MiB, WFF_L = (size_t)DFF * DM * 2;
constexpr size_t WS_WFF2 = 36 * MiB;
constexpr size_t WS_XB = 52 * MiB;
constexpr size_t WS_P = 181 * MiB;
constexpr size_t WS_VT = 598 * MiB;
constexpr size_t WS_MIX = 660 * MiB;
constexpr size_t WS_HDN = WS_P;
constexpr size_t WS_KS = 789 * MiB, KS_L = (size_t)8 * SKV * 384 * 2;
constexpr size_t WS_VTS = 803 * MiB, VTS_L = (size_t)8 * 6 * 64 * SKV * 2;
constexpr size_t WS_END = 817 * MiB;
static_assert(WS_XB + (size_t)MT * DM * 2 <= WS_P && WS_P + (size_t)MT * PP * 2 <= WS_VT && WS_VT + (size_t)MP * 384 * 2 <= WS_MIX, "ws map");
static_assert(WS_MIX + (size_t)MT * DM * 2 <= WS_KS && WS_HDN + (size_t)MT * DFF * 2 <= WS_KS && WS_KS + 2 * KS_L <= WS_VTS && WS_VTS + 2 * VTS_L <= WS_END, "ws map");

constexpr size_t O_Y = 0, O_KP = 67239936, O_VP = 117571584, O_HP = 167903232, O_KS = 169476096, O_VS = 169574400, O_HS = 169672704, O_MV = 170065920;

constexpr int LDS_RING = 131072, LDS_BYTES = LDS_RING + 256;

DI unsigned cvt_pk(float lo, float hi) { typedef float f2 __attribute__((ext_vector_type(2))); typedef __bf16 b2 __attribute__((ext_vector_type(2))); f2 v = {lo, hi}; b2 b = __builtin_convertvector(v, b2); return __builtin_bit_cast(unsigned, b); }
DI bf16_t f2bf(float f) { return (bf16_t)(cvt_pk(f, 0.f) & 0xffffu); }
DI float bf2f(bf16_t b) { return __uint_as_float((unsigned)b << 16); }
DI float wave_sum(float v) {
#pragma unroll
    for (int o = 1; o < 64; o <<= 1) v += __shfl_xor(v, o);
    return v;
}
DI int crow(int r, int hi) { return (r & 3) + 8 * (r >> 2) + 4 * hi; }
DI float fexp2(float x) { return __builtin_amdgcn_exp2f(x); }
DI float flog2(float x) { return __builtin_amdgcn_logf(x); }

DI int ltid() { int t = threadIdx.x; asm volatile("" : "+v"(t)); return t; }
DI int lbid() { int b = blockIdx.x; asm volatile("" : "+s"(b)); return b; }
DI int lgdim() { int b = gridDim.x; asm volatile("" : "+s"(b)); return b; }
struct Params { const float* in[19]; float* out; unsigned char* ws; };
typedef const __attribute__((address_space(4))) Params* KP;
DI Params load_params(KP k) { Params p;
#pragma unroll
    for (int i = 0; i < 19; ++i) p.in[i] = k->in[i];
    p.out = k->out; p.ws = k->ws; return p; }
DI KP kargs() { KP k = (KP)__builtin_amdgcn_kernarg_segment_ptr(); asm volatile("" : "+s"(k)); return k; }

struct EpiG1 {
    static constexpr bool PERM = true, AFTER_DRAIN = false;
    bf16_t* P; float* outK; float* outV; bf16_t* Vt;
    __device__ __forceinline__ void operator()(const f32x4 (&acc)[2][2][4][2], const pg8::Unit& u, int wr, int wc, int fr, int fq) const {
        const int row0 = u.pm * 256 + wr * 64 + fr;
#pragma unroll
        for (int bj = 0; bj < 2; ++bj) {
            const int colh = u.pn * 256 + bj * 128;
            if (colh >= NIN) continue;
            const int col0 = colh + wc * 32 + 8 * fq;
            const float sc = colh < C_K ? QSCALE : 1.f;
#pragma unroll
            for (int ai = 0; ai < 2; ++ai)
#pragma unroll
                for (int m = 0; m < 4; ++m) {
                    const int row = row0 + ai * 128 + m * 16;
                    const f32x4 v0 = acc[ai][bj][m][0], v1 = acc[ai][bj][m][1];
                    u32x4 w; w.x = cvt_pk(v0[0] * sc, v0[1] * sc); w.y = cvt_pk(v0[2] * sc, v0[3] * sc); w.z = cvt_pk(v1[0] * sc, v1[1] * sc); w.w = cvt_pk(v1[2] * sc, v1[3] * sc);
                    *(u32x4*)(P + (size_t)row * PP + col0) = w;
                    if (colh >= C_K && colh < C_V) {
                        float* o = outK + (size_t)row * 384 + (col0 - C_K); *(f32x4*)o = v0; *(f32x4*)(o + 4) = v1;
                    } else if (colh >= C_V && colh < C_U) {
                        float* o = outV + (size_t)row * 384 + (col0 - C_V); *(f32x4*)o = v0; *(f32x4*)(o + 4) = v1;
                        const int b = row >> 11, s = row & 2047, hd = col0 - C_V;
                        bf16_t* vt = Vt + ((size_t)b * 384 + hd) * SEQ + s;
                        vt[0 * SEQ] = (bf16_t)(w.x & 0xffffu); vt[1 * SEQ] = (bf16_t)(w.x >> 16); vt[2 * SEQ] = (bf16_t)(w.y & 0xffffu); vt[3 * SEQ] = (bf16_t)(w.y >> 16);
                        vt[4 * SEQ] = (bf16_t)(w.z & 0xffffu); vt[5 * SEQ] = (bf16_t)(w.z >> 16); vt[6 * SEQ] = (bf16_t)(w.w & 0xffffu); vt[7 * SEQ] = (bf16_t)(w.w >> 16);
                    }
                }
        }
    }
};
struct EpiRelu2 {
    static constexpr bool PERM = true, AFTER_DRAIN = false;
    bf16_t* O;
    __device__ __forceinline__ void operator()(const f32x4 (&acc)[2][2][4][2], const pg8::Unit& u, int wr, int wc, int fr, int fq) const {
        const int row0 = u.pm * 256 + wr * 64 + fr, col0 = u.pn * 256 + wc * 32 + 8 * fq;
#pragma unroll
        for (int ai = 0; ai < 2; ++ai)
#pragma unroll
            for (int m = 0; m < 4; ++m) {
                bf16_t* rowp = O + (size_t)(row0 + ai * 128 + m * 16) * DFF + col0;
#pragma unroll
                for (int bj = 0; bj < 2; ++bj) {
                    f32x4 v0 = acc[ai][bj][m][0], v1 = acc[ai][bj][m][1];
#pragma unroll
                    for (int j = 0; j < 4; ++j) { const float a = fmaxf(v0[j], 0.f), b = fmaxf(v1[j], 0.f); v0[j] = a * a; v1[j] = b * b; }
                    u32x4 w; w.x = cvt_pk(v0[0], v0[1]); w.y = cvt_pk(v0[2], v0[3]); w.z = cvt_pk(v1[0], v1[1]); w.w = cvt_pk(v1[2], v1[3]);
                    *(u32x4*)(rowp + bj * 128) = w;
                }
            }
    }
};
struct EpiRes {
    static constexpr bool PERM = false, AFTER_DRAIN = false;
    const float* res; float* Y;
    __device__ __forceinline__ void operator()(const f32x4 (&acc)[2][2][4][2], const pg8::Unit& u, int wr, int wc, int fr, int fq) const {
        const int row0 = u.pm * 256 + wr * 64 + fr, col0 = u.pn * 256 + wc * 32 + 4 * fq;
#pragma unroll
        for (int ai = 0; ai < 2; ++ai)
#pragma unroll
            for (int m = 0; m < 4; ++m) {
                const size_t off = (size_t)(row0 + ai * 128 + m * 16) * DM + col0;
#pragma unroll
                for (int bj = 0; bj < 2; ++bj)
#pragma unroll
                    for (int n = 0; n < 2; ++n) {
                        const f32x4 r = *(const f32x4*)(res + off + bj * 128 + n * 16);
                        *(f32x4*)(Y + off + bj * 128 + n * 16) = r * ALPHA + acc[ai][bj][m][n];
                    }
            }
    }
};

template <class F> DI void small_gemm(LAS unsigned char* lds, const bf16_t* A, const bf16_t* Bt, int K, int N, const F& epi) {
    const int tid = ltid(), lane = tid & 63, wave = tid >> 6, n32 = lane & 31, hi = lane >> 5;
    const int nunits = 4 * (N / 32), kw = K / 8; const int bid = lbid(), gdim = lgdim();
    LAS float* red = (LAS float*)lds;
    for (int u = bid; u < nunits; u += gdim) {
        const int mt = u & 3, nt = u >> 2;
        const bf16_t* ap = A + (size_t)(32 * mt + n32) * K + wave * kw + 8 * hi;
        const bf16_t* bp = Bt + (size_t)(32 * nt + n32) * K + wave * kw + 8 * hi;
        f32x16 acc;
#pragma unroll
        for (int r = 0; r < 16; ++r) acc[r] = 0.f;
#pragma unroll 8
        for (int kk = 0; kk < kw; kk += 16) acc = MFMA32(*(const bf16x8*)(ap + kk), *(const bf16x8*)(bp + kk), acc);
#pragma unroll
        for (int r = 0; r < 16; ++r) red[(wave * 32 + crow(r, hi)) * 33 + n32] = acc[r];
        __syncthreads();
        const int row = tid >> 4, c0 = (tid & 15) * 2;
        float v0 = 0.f, v1 = 0.f;
#pragma unroll
        for (int w = 0; w < 8; ++w) { v0 += red[(w * 32 + row) * 33 + c0]; v1 += red[(w * 32 + row) * 33 + c0 + 1]; }
        epi(32 * mt + row, 32 * nt + c0, v0, v1);
        __syncthreads();
    }
}

DI void transpose_item(const float* W, int K, int N, bf16_t* WT, LAS float* scr, int item, int lane) {
    const int nblk = N / 32, kb = item / nblk, nb = item % nblk, k0 = 64 * kb, n0 = 32 * nb;
#pragma unroll 8
    for (int i = 0; i < 32; ++i) { const int kk = 2 * i + (lane >> 5); scr[kk * 33 + (lane & 31)] = W[(size_t)(k0 + kk) * N + n0 + (lane & 31)]; }
    __builtin_amdgcn_s_waitcnt(0); asm volatile("" ::: "memory");
    const int c = lane & 7;
#pragma unroll
    for (int j = 0; j < 4; ++j) { const int n = (lane >> 3) + 8 * j; const LAS float* s = scr + (8 * c) * 33 + n;
        u32x4 o; o.x = cvt_pk(s[0 * 33], s[1 * 33]); o.y = cvt_pk(s[2 * 33], s[3 * 33]); o.z = cvt_pk(s[4 * 33], s[5 * 33]); o.w = cvt_pk(s[6 * 33], s[7 * 33]);
        *(u32x4*)(WT + (size_t)(n0 + n) * K + k0 + 8 * c) = o; }
    __builtin_amdgcn_s_waitcnt(0); asm volatile("" ::: "memory");
}

DI void prologue(LAS unsigned char* lds) {
    const Params p = load_params(kargs());
    const int tid = ltid(), lane = tid & 63, wave = tid >> 6; const int bid = lbid(), gdim = lgdim();
    const int gw = bid * NWAVE + wave, ngw = gdim * NWAVE;
    LAS float* scr = (LAS float*)(lds + wave * 16384);
    constexpr int I_IN = (DM / 64) * (NIN / 32), I_OUT = (DM / 64) * (DM / 32), I_F1 = (DM / 64) * (DFF / 32), I_F2 = (DFF / 64) * (DM / 32), I_L = I_IN + I_OUT + I_F1 + I_F2;
    for (int it = gw; it < DEPTH * I_L; it += ngw) {
        const int l = it / I_L; int r = it % I_L;
        if (r < I_IN) { transpose_item(p.in[5] + (size_t)l * DM * NIN, DM, NIN, (bf16_t*)(p.ws + WS_WIN + l * WIN_L), scr, r, lane); continue; } r -= I_IN;
        if (r < I_OUT) { transpose_item(p.in[6] + (size_t)l * DM * DM, DM, DM, (bf16_t*)(p.ws + WS_WOUT + l * WOUT_L), scr, r, lane); continue; } r -= I_OUT;
        if (r < I_F1) { transpose_item(p.in[15] + (size_t)l * DM * DFF, DM, DFF, (bf16_t*)(p.ws + WS_WFF1 + l * WFF_L), scr, r, lane); continue; } r -= I_F1;
        transpose_item(p.in[16] + (size_t)l * DFF * DM, DFF, DM, (bf16_t*)(p.ws + WS_WFF2 + l * WFF_L), scr, r, lane);
    }
    const size_t gt = (size_t)bid * NTHR + tid, ngt = (size_t)gdim * NTHR;
    for (size_t i = gt; i < (size_t)DEPTH * 128 * DM / 8; i += ngt) {
        const size_t l = i / (128 * DM / 8), r = i % (128 * DM / 8);
        *(u32x4*)((bf16_t*)(p.ws + WS_WIN + l * WIN_L) + (size_t)NIN * DM + r * 8) = (u32x4){0u, 0u, 0u, 0u};
    }
    bf16_t* XB = (bf16_t*)(p.ws + WS_XB);
    for (size_t i = gt; i < (size_t)MT * DM / 8; i += ngt) {
        const size_t row = i >> 7, c8 = (i & 127) * 8;
        const float* src = row < MP ? p.in[0] + row * DM + c8 : p.in[1] + (row - MP) * DM + c8;
        const f32x4 a = *(const f32x4*)src, b = *(const f32x4*)(src + 4);
        u32x4 o; o.x = cvt_pk(a[0], a[1]); o.y = cvt_pk(a[2], a[3]); o.z = cvt_pk(b[0], b[1]); o.w = cvt_pk(b[2], b[3]);
        *(u32x4*)(XB + row * DM + c8) = o;
    }
    for (size_t i = gt; i < (size_t)DEPTH * 8 * SKV * 384 / 8; i += ngt) {
        const size_t c8 = (i % 48) * 8, s = (i / 48) % SKV, lb = i / (48 * SKV);
        if (s >= 1024 && s < 1040) continue;
        u32x4 o = (u32x4){0u, 0u, 0u, 0u};
        if (s < 1024) { const float* src = p.in[2] + (lb * 1024 + s) * 384 + c8; const f32x4 a = *(const f32x4*)src, b = *(const f32x4*)(src + 4);
            o.x = cvt_pk(a[0], a[1]); o.y = cvt_pk(a[2], a[3]); o.z = cvt_pk(b[0], b[1]); o.w = cvt_pk(b[2], b[3]); }
        *(u32x4*)((bf16_t*)(p.ws + WS_KS) + (lb * SKV + s) * 384 + c8) = o;
    }
    for (size_t i = gt; i < (size_t)DEPTH * 8 * (SKV / 8) * 384; i += ngt) {
        const size_t hd = i % 384, s8 = (i / 384) % (SKV / 8), lb = i / (384 * (SKV / 8));
        const size_t s0 = s8 * 8;
        if (s0 >= 1024 && s0 < 1040) continue;
        u32x4 o = (u32x4){0u, 0u, 0u, 0u};
        if (s0 < 1024) { const float* src = p.in[3] + (lb * 1024 + s0) * 384 + hd;
            o.x = cvt_pk(src[0], src[384]); o.y = cvt_pk(src[2 * 384], src[3 * 384]); o.z = cvt_pk(src[4 * 384], src[5 * 384]); o.w = cvt_pk(src[6 * 384], src[7 * 384]); }
        *(u32x4*)((bf16_t*)(p.ws + WS_VTS) + (lb * 384 + hd) * SKV + s0) = o;
    }
}

DI void attn_wave_unit(const bf16_t* Q, int qpitch, int nvalid, int qpos0, const bf16_t* Kb, int kpitch, const bf16_t* Vt, int vpitch, int ntiles,
                       bf16_t* O, int opitch, int lane) {
    const int t = lane & 31, hi = lane >> 5;
    const int tq = t < nvalid ? t : nvalid - 1;
    bf16x8 qf[4];
#pragma unroll
    for (int ks = 0; ks < 4; ++ks) qf[ks] = *(const bf16x8*)(Q + (size_t)tq * qpitch + 16 * ks + 8 * hi);
    const int tpos = qpos0 + t;
    const int koff = (t & 16) | ((t & 4) << 1) | ((t & 8) >> 1) | (t & 3);
    const bf16_t* kp = Kb + (size_t)koff * kpitch + 8 * hi;
    const bf16_t* vp = Vt + (size_t)t * vpitch + 8 * hi;
    f32x16 o0, o1;
#pragma unroll
    for (int r = 0; r < 16; ++r) { o0[r] = 0.f; o1[r] = 0.f; }
    float R = 0.f;
    for (int kt = ntiles - 1; kt >= 0; --kt) {
        const int s0 = kt * 32;
        bf16x8 kf[4], vf[2][2];
#pragma unroll
        for (int ks = 0; ks < 4; ++ks) kf[ks] = *(const bf16x8*)(kp + (size_t)s0 * kpitch + 16 * ks);
#pragma unroll
        for (int dd = 0; dd < 2; ++dd)
#pragma unroll
            for (int m = 0; m < 2; ++m) vf[dd][m] = *(const bf16x8*)(vp + (size_t)(32 * dd) * vpitch + s0 + 16 * m);
        f32x16 c;
#pragma unroll
        for (int r = 0; r < 16; ++r) c[r] = 0.f;
#pragma unroll
        for (int ks = 0; ks < 4; ++ks) c = MFMA32(kf[ks], qf[ks], c);
        const bool diag = (s0 + 31 >= qpos0);
        float L[16];
#pragma unroll
        for (int r = 0; r < 16; ++r) { const float z = c[r]; const float e = fexp2(-fabsf(z)); L[r] = -(fmaxf(z, 0.f) + flog2(1.f + e)); }
        if (diag) {
#pragma unroll
            for (int r = 0; r < 16; ++r) { const int key = s0 + 16 * (r >> 3) + 8 * hi + (r & 7); if (key >= tpos) L[r] = 0.f; }
        }
        float a1 = 0.f, a0 = 0.f;
#pragma unroll
        for (int r = 15; r >= 8; --r) { a1 += L[r]; L[r] = a1; }
#pragma unroll
        for (int r = 7; r >= 0; --r) { a0 += L[r]; L[r] = a0; }
        const float g0p = __shfl_xor(a0, 32), g1p = __shfl_xor(a1, 32);
        const float off1 = R + (hi ? 0.f : g1p);
        const float off0 = R + a1 + g1p + (hi ? 0.f : g0p);
        R += (a0 + a1) + (g0p + g1p);
        float w[16];
#pragma unroll
        for (int r = 0; r < 16; ++r) w[r] = fexp2(c[r] + L[r] + (r < 8 ? off0 : off1));
        if (diag) {
#pragma unroll
            for (int r = 0; r < 16; ++r) { const int key = s0 + 16 * (r >> 3) + 8 * hi + (r & 7); if (key >= tpos) w[r] = 0.f; }
        }
        u32x4 p0, p1;
        p0.x = cvt_pk(w[0], w[1]); p0.y = cvt_pk(w[2], w[3]); p0.z = cvt_pk(w[4], w[5]); p0.w = cvt_pk(w[6], w[7]);
        p1.x = cvt_pk(w[8], w[9]); p1.y = cvt_pk(w[10], w[11]); p1.z = cvt_pk(w[12], w[13]); p1.w = cvt_pk(w[14], w[15]);
        const bf16x8 wb0 = __builtin_bit_cast(bf16x8, p0), wb1 = __builtin_bit_cast(bf16x8, p1);
        o0 = MFMA32(vf[0][0], wb0, o0); o0 = MFMA32(vf[0][1], wb1, o0);
        o1 = MFMA32(vf[1][0], wb0, o1); o1 = MFMA32(vf[1][1], wb1, o1);
    }
    if (t < nvalid) {
#pragma unroll
        for (int g = 0; g < 4; ++g) {
            u32x2 a; a.x = cvt_pk(o0[4 * g], o0[4 * g + 1]); a.y = cvt_pk(o0[4 * g + 2], o0[4 * g + 3]);
            u32x2 b; b.x = cvt_pk(o1[4 * g], o1[4 * g + 1]); b.y = cvt_pk(o1[4 * g + 2], o1[4 * g + 3]);
            *(u32x2*)(O + (size_t)t * opitch + 8 * g + 4 * hi) = a;
            *(u32x2*)(O + (size_t)t * opitch + 32 + 8 * g + 4 * hi) = b;
        }
    }
}

DI void gmlp_unit(LAS unsigned char* lds, const bf16_t* Prow0, int ntok, bf16_t* mixrow0, float* vn_out,
                  const float* lng, const float* lnb, const float* ws, const float* bs) {
    constexpr int VP = 136;
    LAS bf16_t* vnT = (LAS bf16_t*)lds;
    const int tid = ltid(), lane = tid & 63, wave = tid >> 6;
    const f32x4 gg = *(const f32x4*)(lng + 4 * lane), bb = *(const f32x4*)(lnb + 4 * lane);
    for (int t = wave; t < 128; t += 8) {
        f32x4 vn = (f32x4){0.f, 0.f, 0.f, 0.f};
        if (t < ntok) {
            const u32x2 raw = *(const u32x2*)(Prow0 + (size_t)t * PP + C_VB + 4 * lane);
            f32x4 v; v[0] = __uint_as_float(raw.x << 16); v[1] = __uint_as_float(raw.x & 0xffff0000u); v[2] = __uint_as_float(raw.y << 16); v[3] = __uint_as_float(raw.y & 0xffff0000u);
            const float mean = wave_sum((v[0] + v[1]) + (v[2] + v[3])) * (1.f / 256.f);
            v = v - mean;
            const float var = wave_sum((v[0] * v[0] + v[1] * v[1]) + (v[2] * v[2] + v[3] * v[3])) * (1.f / 256.f);
            const float rstd = 1.0f / sqrtf(var + 1e-5f);
            vn = v * rstd * gg + bb;
            if (vn_out) *(f32x4*)(vn_out + (size_t)t * 256 + 4 * lane) = vn;
        }
#pragma unroll
        for (int j = 0; j < 4; ++j) vnT[(4 * lane + j) * VP + t] = f2bf(vn[j]);
    }
    __syncthreads();
    const int n = lane & 31, hi = lane >> 5, c = 32 * wave + n, g = wave >> 1;
    const int nmt = (ntok + 31) / 32;
    for (int mt = 0; mt < nmt; ++mt) {
        f32x16 acc;
#pragma unroll
        for (int r = 0; r < 16; ++r) acc[r] = 0.f;
        const int trow = 32 * mt + n;
        for (int ks = 0; ks < 2 * (mt + 1); ++ks) {
            const int sb = 16 * ks + 8 * hi;
            const float* wp = ws + ((size_t)g * 128 + trow) * 128 + sb;
            f32x4 w0 = *(const f32x4*)wp, w1 = *(const f32x4*)(wp + 4);
#pragma unroll
            for (int j = 0; j < 4; ++j) { if (sb + j > trow) w0[j] = 0.f; if (sb + 4 + j > trow) w1[j] = 0.f; }
            u32x4 pa; pa.x = cvt_pk(w0[0], w0[1]); pa.y = cvt_pk(w0[2], w0[3]); pa.z = cvt_pk(w1[0], w1[1]); pa.w = cvt_pk(w1[2], w1[3]);
            const bf16x8 b = *(const LAS bf16x8*)(vnT + c * VP + sb);
            acc = MFMA32(__builtin_bit_cast(bf16x8, pa), b, acc);
        }
#pragma unroll
        for (int r = 0; r < 16; ++r) {
            const int t = 32 * mt + crow(r, hi);
            if (t < ntok) {
                const float uval = bf2f(Prow0[(size_t)t * PP + C_U + c]);
                mixrow0[(size_t)t * DM + 384 + c] = f2bf(uval * (acc[r] + bs[g * 128 + t]));
            }
        }
    }
    __syncthreads();
}

DI void hgrn_unit(LAS unsigned char* lds, const bf16_t* Prow0, int ntok, int h, int layer, const float* S0, float* Sout, bf16_t* mixrow0,
                  const float* lb_logits, const float* normw) {
    const int tid = ltid(), e = tid & 63, dg = tid >> 6;
    LAS float* sQ = (LAS float*)lds; LAS float* sF = sQ + 2048; LAS float* sK = sF + 2048; LAS float* sV = sK + 2048; LAS float* sG = sV + 2048; LAS float* sPO = sG + 2048;
    float S[8];
#pragma unroll
    for (int i = 0; i < 8; ++i) S[i] = S0 ? S0[(8 * dg + i) * 64 + e] : 0.f;
    float lbv = 0.f;
    if (layer > 0) { const float x0 = lb_logits[64 * h + e], x1 = lb_logits[384 + 64 * h + e]; lbv = 1.f / (1.f + __expf(x0 - x1)); }
    const float nw = normw[64 * h + e];
    for (int t0 = 0; t0 < ntok; t0 += 32) {
        const int nt = (ntok - t0) < 32 ? (ntok - t0) : 32;
#pragma unroll
        for (int j = 0; j < 4; ++j) {
            const int idx = tid + 512 * j, t = idx >> 6;
            if (t < nt) {
                const bf16_t* rp = Prow0 + (size_t)(t0 + t) * PP + 64 * h + e;
                const float zq = bf2f(rp[C_QC]), zf = bf2f(rp[C_FC]), vi = bf2f(rp[C_IC]), zg = bf2f(rp[C_GC]);
                const float sp = 1.f / (1.f + __expf(-zf)), sn = 1.f / (1.f + __expf(zf));
                sQ[idx] = zq / (1.f + __expf(-zq)); sF[idx] = lbv + (1.f - lbv) * sp; sK[idx] = (1.f - lbv) * sn; sV[idx] = vi; sG[idx] = 1.f / (1.f + __expf(-zg));
            }
        }
        __syncthreads();
#pragma unroll 2
        for (int t = 0; t < nt; ++t) {
            const f32x4 fa = *(const LAS f32x4*)(sF + t * 64 + 8 * dg), fb = *(const LAS f32x4*)(sF + t * 64 + 8 * dg + 4);
            const f32x4 ka = *(const LAS f32x4*)(sK + t * 64 + 8 * dg), kb = *(const LAS f32x4*)(sK + t * 64 + 8 * dg + 4);
            const f32x4 qa = *(const LAS f32x4*)(sQ + t * 64 + 8 * dg), qb = *(const LAS f32x4*)(sQ + t * 64 + 8 * dg + 4);
            const float v = sV[t * 64 + e];
            float po = 0.f;
#pragma unroll
            for (int i = 0; i < 4; ++i) { S[i] = fa[i] * S[i] + ka[i] * v; po += qa[i] * S[i]; }
#pragma unroll
            for (int i = 0; i < 4; ++i) { S[4 + i] = fb[i] * S[4 + i] + kb[i] * v; po += qb[i] * S[4 + i]; }
            sPO[(dg * 32 + t) * 64 + e] = po;
        }
        __syncthreads();
#pragma unroll
        for (int j = 0; j < 4; ++j) {
            const int t = 4 * dg + j;
            if (t < nt) {
                float o = 0.f;
#pragma unroll
                for (int w = 0; w < 8; ++w) o += sPO[(w * 32 + t) * 64 + e];
                const float ss = wave_sum(o * o);
                const float r = 1.0f / sqrtf(ss * (1.f / 64.f) + 1e-6f);
                mixrow0[(size_t)(t0 + t) * DM + 640 + 64 * h + e] = f2bf(o * r * nw * sG[t * 64 + e]);
            }
        }
        __syncthreads();
    }
#pragma unroll
    for (int i = 0; i < 8; ++i) Sout[(8 * dg + i) * 64 + e] = S[i];
}

constexpr int U_HP = 192, U_AS = 6, U_AP = 768, U_GP = 512, U_HS = 48, U_GS = 8;
constexpr int U0_AS = U_HP, U0_AP = U0_AS + U_AS, U0_GP = U0_AP + U_AP, U0_HS = U0_GP + U_GP, U0_GS = U0_HS + U_HS, U_TOTAL = U0_GS + U_GS;

DI void mix_phase(LAS unsigned char* lds, int l) {
    const int tid = ltid(), lane = tid & 63, wave = tid >> 6;
    volatile LAS int* sU = (volatile LAS int*)(lds + LDS_RING);
    for (;;) {
        { const KP k = kargs(); if (tid == 0) *sU = (int)atomicAdd((unsigned*)(k->ws + WS_CTL) + 64 * (1 + l), 1u); }
        __syncthreads();
        const int u = __builtin_amdgcn_readfirstlane(*sU);
        __syncthreads();
        if (u >= U_TOTAL) break;
        const KP k = kargs();
        unsigned char* ws = k->ws;
        const bf16_t* P = (const bf16_t*)(ws + WS_P);
        bf16_t* MIXB = (bf16_t*)(ws + WS_MIX);
        if (u < U0_AS) {
            const int b = u / 6, h = u % 6;
            hgrn_unit(lds, P + (size_t)b * SEQ * PP, SEQ, h, l, nullptr, k->out + O_HP + ((size_t)(l * NBATCH + b) * 6 + h) * 4096,
                      MIXB + (size_t)b * SEQ * DM, k->in[11], k->in[12] + l * 384);
        } else if (u < U0_AP) {
            const int su = (u - U0_AS) * 8 + wave, b = su / 6, h = su % 6;
            const bf16_t* KS = (const bf16_t*)(ws + WS_KS + l * KS_L);
            const bf16_t* VTS = (const bf16_t*)(ws + WS_VTS + l * VTS_L);
            attn_wave_unit(P + (size_t)(MP + 16 * b) * PP + C_Q + 64 * h, PP, 16, 1024, KS + (size_t)b * SKV * 384 + 64 * h, 384,
                           VTS + (size_t)(b * 384 + 64 * h) * SKV, SKV, SKV / 32, MIXB + (size_t)(MP + 16 * b) * DM + 64 * h, DM, lane);
        } else if (u < U0_GP) {
            const int au = u - U0_AP, bh = au >> 2, b = bh / 6, h = bh % 6, pi = (au & 3) * 8 + wave;
            const bf16_t* Kb = P + (size_t)b * SEQ * PP + C_K + 64 * h;
            const bf16_t* Vt = (const bf16_t*)(ws + WS_VT) + (size_t)(b * 384 + 64 * h) * SEQ;
#pragma unroll 1
            for (int kk = 0; kk < 2; ++kk) {
                const int qt = kk ? 63 - pi : pi;
                attn_wave_unit(P + (size_t)(b * SEQ + 32 * qt) * PP + C_Q + 64 * h, PP, 32, 32 * qt, Kb, PP, Vt, SEQ, qt + 1,
                               MIXB + (size_t)(b * SEQ + 32 * qt) * DM + 64 * h, DM, lane);
            }
        } else if (u < U0_HS) {
            const int gu = u - U0_GP;
            gmlp_unit(lds, P + (size_t)gu * 128 * PP, 128, MIXB + (size_t)gu * 128 * DM, nullptr,
                      k->in[7] + l * 256, k->in[8] + l * 256, k->in[9] + (size_t)l * 4 * 128 * 128, k->in[10] + l * 4 * 128);
        } else if (u < U0_GS) {
            const int hu = u - U0_HS, b = hu / 6, h = hu % 6;
            hgrn_unit(lds, P + (size_t)(MP + 16 * b) * PP, 16, h, l, k->in[4] + ((size_t)(l * 8 + b) * 6 + h) * 4096, k->out + O_HS + ((size_t)(l * 8 + b) * 6 + h) * 4096,
                      MIXB + (size_t)(MP + 16 * b) * DM, k->in[11], k->in[12] + l * 384);
        } else {
            const int b = u - U0_GS;
            gmlp_unit(lds, P + (size_t)(MP + 16 * b) * PP, 16, MIXB + (size_t)(MP + 16 * b) * DM, k->out + O_MV + (size_t)(l * 8 + b) * 16 * 256,
                      k->in[7] + l * 256, k->in[8] + l * 256, k->in[9] + (size_t)l * 4 * 128 * 128, k->in[10] + l * 4 * 128);
        }
    }
}

DI void ln_phase(float* Y, bf16_t* XB, const float* g, const float* b) {
    const int tid = ltid(), lane = tid & 63, wave = tid >> 6;
    const int gw = lbid() * NWAVE + wave, ngw = lgdim() * NWAVE;
    f32x4 gg[4], bb[4];
#pragma unroll
    for (int j = 0; j < 4; ++j) { gg[j] = *(const f32x4*)(g + 4 * lane + 256 * j); bb[j] = *(const f32x4*)(b + 4 * lane + 256 * j); }
    for (int row = gw; row < MT; row += ngw) {
        float* yr = Y + (size_t)row * DM + 4 * lane;
        f32x4 v[4]; float s = 0.f;
#pragma unroll
        for (int j = 0; j < 4; ++j) { v[j] = *(const f32x4*)(yr + 256 * j); s += (v[j][0] + v[j][1]) + (v[j][2] + v[j][3]); }
        const float mean = wave_sum(s) * (1.f / DM); float s2 = 0.f;
#pragma unroll
        for (int j = 0; j < 4; ++j) { v[j] = v[j] - mean; s2 += (v[j][0] * v[j][0] + v[j][1] * v[j][1]) + (v[j][2] * v[j][2] + v[j][3] * v[j][3]); }
        const float rstd = 1.0f / sqrtf(wave_sum(s2) * (1.f / DM) + 1e-5f);
#pragma unroll
        for (int j = 0; j < 4; ++j) {
            const f32x4 o = v[j] * rstd * gg[j] + bb[j];
            *(f32x4*)(yr + 256 * j) = o;
            u32x2 w; w.x = cvt_pk(o[0], o[1]); w.y = cvt_pk(o[2], o[3]);
            *(u32x2*)(XB + (size_t)row * DM + 4 * lane + 256 * j) = w;
        }
    }
}

DI void g1_phase(LAS unsigned char* lds, int l) {
    const KP pk = kargs(); float* out = pk->out; unsigned char* ws = pk->ws;
    bf16_t* XB = (bf16_t*)(ws + WS_XB); bf16_t* P = (bf16_t*)(ws + WS_P);
    const bf16_t* WinT = (const bf16_t*)(ws + WS_WIN + l * WIN_L);
    {
        pg8::Gemm g{XB, WinT, MP, NINP, DM}; pg8::StaticOrder S; S.init(MP, NINP, lgdim(), lbid());
        EpiG1 E{P, out + O_KP + (size_t)l * MP * 384, out + O_VP + (size_t)l * MP * 384, (bf16_t*)(ws + WS_VT)};
        pg8::gemm_phase<EpiG1, pg8::StaticOrder, true, true>(lds, g, S, E);
    }
    float* oks = out + O_KS + (size_t)l * MS * 384; float* ovs = out + O_VS + (size_t)l * MS * 384;
    bf16_t* KS = (bf16_t*)(ws + WS_KS + l * KS_L); bf16_t* VTS = (bf16_t*)(ws + WS_VTS + l * VTS_L);
    small_gemm(lds, XB + (size_t)MP * DM, WinT, DM, NIN, [=](int sr, int c, float v0, float v1) {
        const float sc = c < C_K ? QSCALE : 1.f;
        const unsigned pkv = cvt_pk(v0 * sc, v1 * sc);
        *(unsigned*)(P + (size_t)(MP + sr) * PP + c) = pkv;
        const int b = sr >> 4, t = sr & 15;
        if (c >= C_K && c < C_V) { oks[(size_t)sr * 384 + c - C_K] = v0; oks[(size_t)sr * 384 + c - C_K + 1] = v1;
            *(unsigned*)(KS + ((size_t)b * SKV + 1024 + t) * 384 + c - C_K) = pkv; }
        else if (c >= C_V && c < C_U) { ovs[(size_t)sr * 384 + c - C_V] = v0; ovs[(size_t)sr * 384 + c - C_V + 1] = v1;
            bf16_t* vt = VTS + ((size_t)b * 384 + (c - C_V)) * SKV + 1024 + t; vt[0] = (bf16_t)(pkv & 0xffffu); vt[SKV] = (bf16_t)(pkv >> 16); }
    });
}
DI void g2_phase(LAS unsigned char* lds, int l) {
    const KP pk = kargs(); float* Y = pk->out + O_Y; unsigned char* ws = pk->ws;
    bf16_t* MIXB = (bf16_t*)(ws + WS_MIX); const bf16_t* WoutT = (const bf16_t*)(ws + WS_WOUT + l * WOUT_L);
    {
        pg8::Gemm g{MIXB, WoutT, MP, DM, DM}; pg8::StaticOrder S; S.init(MP, DM, lgdim(), lbid());
        EpiRes E{l == 0 ? pk->in[0] : Y, Y};
        pg8::gemm_phase<EpiRes, pg8::StaticOrder, true, true>(lds, g, S, E);
    }
    const float* rs = l == 0 ? pk->in[1] : Y + (size_t)MP * DM;
    small_gemm(lds, MIXB + (size_t)MP * DM, WoutT, DM, DM, [=](int sr, int c, float v0, float v1) {
        float* y = Y + (size_t)(MP + sr) * DM + c; const float r0 = rs[(size_t)sr * DM + c], r1 = rs[(size_t)sr * DM + c + 1]; y[0] = ALPHA * r0 + v0; y[1] = ALPHA * r1 + v1; });
}
DI void g3_phase(LAS unsigned char* lds, int l) {
    const KP pk = kargs(); unsigned char* ws = pk->ws;
    bf16_t* XB = (bf16_t*)(ws + WS_XB); bf16_t* HDN = (bf16_t*)(ws + WS_HDN); const bf16_t* Wf1T = (const bf16_t*)(ws + WS_WFF1 + l * WFF_L);
    {
        pg8::Gemm g{XB, Wf1T, MP, DFF, DM}; pg8::StaticOrder S; S.init(MP, DFF, lgdim(), lbid());
        EpiRelu2 E{HDN};
        pg8::gemm_phase<EpiRelu2, pg8::StaticOrder, true, true>(lds, g, S, E);
    }
    small_gemm(lds, XB + (size_t)MP * DM, Wf1T, DM, DFF, [=](int sr, int c, float v0, float v1) {
        const float a = fmaxf(v0, 0.f), b = fmaxf(v1, 0.f); *(unsigned*)(HDN + (size_t)(MP + sr) * DFF + c) = cvt_pk(a * a, b * b); });
}
DI void g4_phase(LAS unsigned char* lds, int l) {
    const KP pk = kargs(); float* Y = pk->out + O_Y; unsigned char* ws = pk->ws;
    bf16_t* HDN = (bf16_t*)(ws + WS_HDN); const bf16_t* Wf2T = (const bf16_t*)(ws + WS_WFF2 + l * WFF_L);
    {
        pg8::Gemm g{HDN, Wf2T, MP, DM, DFF}; pg8::StaticOrder S; S.init(MP, DM, lgdim(), lbid());
        EpiRes E{Y, Y};
        pg8::gemm_phase<EpiRes, pg8::StaticOrder, true, true>(lds, g, S, E);
    }
    small_gemm(lds, HDN + (size_t)MP * DFF, Wf2T, DFF, DM, [=](int sr, int c, float v0, float v1) {
        float* y = Y + (size_t)(MP + sr) * DM + c; y[0] = ALPHA * y[0] + v0; y[1] = ALPHA * y[1] + v1; });
}
DI void ln_phase_l(int l, int which) {
    const KP pk = kargs();
    ln_phase(pk->out + O_Y, (bf16_t*)(pk->ws + WS_XB), pk->in[which ? 17 : 13] + l * DM, pk->in[which ? 18 : 14] + l * DM);
}

__global__ void __launch_bounds__(NTHR, 2) fwd(Params p_unused) {
    extern __shared__ __attribute__((aligned(16))) unsigned char lds_raw[];
    LAS unsigned char* lds = (LAS unsigned char*)lds_raw;
    cg::grid_group grid = cg::this_grid();
#ifndef PHM
#define PHM 0xff
#endif
    if (PHM & 1) prologue(lds);
    grid.sync();
#pragma unroll 1
    for (int l = 0; l < DEPTH; ++l) {
        if (PHM & 2) g1_phase(lds, l);
        grid.sync();
        if (PHM & 4) mix_phase(lds, l);
        grid.sync();
        if (PHM & 8) g2_phase(lds, l);
        grid.sync();
        if (PHM & 16) ln_phase_l(l, 0);
        grid.sync();
        if (PHM & 32) g3_phase(lds, l);
        grid.sync();
        if (PHM & 64) g4_phase(lds, l);
        grid.sync();
        if (PHM & 128) ln_phase_l(l, 1);
        if (l + 1 < DEPTH) grid.sync();
    }
}

extern "C" void kernel_launch(void* const* d_in, const int* in_sizes, int n_in, void* d_out, int out_size, void* d_ws, size_t ws_size, hipStream_t stream) {
    static int grid = 0;
    if (grid == 0) {
        if (n_in != 19 || ws_size < WS_END) { fprintf(stderr, "kernel_launch: unexpected n_in %d / ws %zu\n", n_in, ws_size); grid = -1; return; }
        int dev = 0, cus = 0, per_cu = 0;
        hipGetDevice(&dev); hipDeviceGetAttribute(&cus, hipDeviceAttributeMultiprocessorCount, dev);
        if (hipFuncSetAttribute((const void*)fwd, hipFuncAttributeMaxDynamicSharedMemorySize, LDS_BYTES) != hipSuccess) { fprintf(stderr, "kernel_launch: hipFuncSetAttribute failed\n"); grid = -1; return; }
        hipOccupancyMaxActiveBlocksPerMultiprocessor(&per_cu, (const void*)fwd, NTHR, LDS_BYTES);
        (void)hipGetLastError();
        if (per_cu < 1) { fprintf(stderr, "kernel_launch: occupancy query says %d\n", per_cu); per_cu = 1; }
        grid = cus;
    }
    if (grid < 0) return;
    hipMemsetAsync((char*)d_ws + WS_CTL, 0, 4096, stream);
    Params p{};
    for (int i = 0; i < 19; ++i) p.in[i] = (const float*)d_in[i];
    p.out = (float*)d_out; p.ws = (unsigned char*)d_ws;
    void* args[] = {&p};
    hipError_t e = hipLaunchCooperativeKernel((const void*)fwd, dim3(grid), dim3(NTHR), args, LDS_BYTES, stream);
    if (e != hipSuccess) fprintf(stderr, "cooperative launch failed: %s (grid %d)\n", hipGetErrorString(e), grid);
}
```

```cpp
#include <hip/hip_runtime.h>
#include <hip/hip_cooperative_groups.h>
#include <cstdio>
#include <cstdint>
namespace cg = cooperative_groups;
namespace pg8 {
#define PG8_LAS __attribute__((address_space(3)))
typedef unsigned short bf16_t;
typedef short bf16x8 __attribute__((ext_vector_type(8)));
typedef float f32x4 __attribute__((ext_vector_type(4)));
typedef unsigned u32x4 __attribute__((ext_vector_type(4)));
constexpr int BM = 256, BK = 64, HALF = 128, HTB = HALF * BK * 2  , STAGE_BYTES = 8 * HTB, NXCD = 8, WGM = 8;

__host__ __device__ __forceinline__ int lds_byte(int r, int c) { const int st = (r >> 4) * 2 + (c >> 5), rr = r & 15, cc = c & 31, ob = rr * 64 + cc * 2; return st * 1024 + (ob ^ (((ob >> 9) & 1) << 5)); }
__host__ __device__ __forceinline__ void stage_rc(int b, int& R, int& C) { const int st = b / 1024, sb = b % 1024, swz = sb ^ (((sb >> 9) & 1) << 5); R = (st >> 1) * 16 + swz / 64; C = (st & 1) * 32 + (swz % 64) / 2; }
__host__ __device__ __forceinline__ int perm32(int rho) { const int n = rho >> 4, i = rho & 15; return 8 * (i >> 2) + 4 * n + (i & 3); }

struct Unit { int pm, pn; };
struct Gemm { const bf16_t* A; const bf16_t* Bt; int M, N, K; };

struct StaticOrder {
    int nM, nN, nwg, G, c;
    __host__ __device__ void init(int M, int N, int G_, int c_) { nM = M / BM; nN = N / BM; nwg = nM * nN; G = G_; c = c_; }
    __host__ __device__ bool next(int i, Unit& u) const {
        const long L = (long)i * G + c; if (L >= nwg) return false;
        int wgid = (int)L; { const int q = nwg / NXCD, r = nwg % NXCD, xcd = wgid % NXCD, off = wgid / NXCD; wgid = (xcd < r ? xcd * (q + 1) : r * (q + 1) + (xcd - r) * q) + off; }
        const int nig = WGM * nN, gid = wgid / nig, fm = gid * WGM, gsz = (nM - fm) < WGM ? (nM - fm) : WGM;
        u.pm = fm + ((wgid % nig) % gsz); u.pn = (wgid % nig) / gsz; return true;
    }
    __device__ __forceinline__ void a_ready(const Unit&) const {}
    __device__ __forceinline__ void done(const Unit&) const {}
};

template <class Epi, class Sched, bool ALIGN_EPI = false, bool SP2 = false>
__device__ __forceinline__ void gemm_phase(PG8_LAS unsigned char* lds, const Gemm g, const Sched& S, const Epi& E) {
    int tid_l = threadIdx.x; asm volatile("" : "+v"(tid_l)); const int tid = tid_l, wid = __builtin_amdgcn_readfirstlane(tid >> 6), lane = tid & 63, wr = wid >> 2, wc = wid & 3, fr = lane & 15, fq = lane >> 4;
    const int K = g.K, nt = K / BK;
    unsigned voffA[2], voffB[2];
#pragma unroll
    for (int i = 0; i < 2; ++i) { int R, C; stage_rc(tid * 16 + i * 8192, R, C); const int Rb = Epi::PERM ? ((R & ~31) + perm32(R & 31)) : R;
        voffA[i] = (unsigned)(R * K + C) * 2u; voffB[i] = (unsigned)(Rb * K + C) * 2u; }
    const size_t kstep = (size_t)(BK * 2);
    const size_t hstep = (size_t)HALF * K * 2;
    const size_t tstep = 2 * hstep;
    const unsigned ldsw = (unsigned)wid * 1024u;
    const int aoff = lds_byte(wr * 64 + fr, fq * 8), boff = lds_byte(wc * 32 + fr, fq * 8);
#define PG8_SA(b, h) (((b) * 2 + (h)) * HTB)
#define PG8_SB(b, h) ((4 + (b) * 2 + (h)) * HTB)
#define PG8_STAGE(bufoff, gbase, voff) do { _Pragma("unroll") for (int _i = 0; _i < 2; ++_i) \
        __builtin_amdgcn_global_load_lds((const unsigned*)((const char*)(gbase) + (voff)[_i]), (PG8_LAS unsigned*)(lds + (bufoff) + ldsw + _i * 8192), 16, 0, 0); } while (0)
#define PG8_LDA(dst, b, h) do { _Pragma("unroll") for (int m = 0; m < 4; ++m) _Pragma("unroll") for (int k = 0; k < 2; ++k) dst[m][k] = *(const PG8_LAS bf16x8*)(lds + PG8_SA(b, h) + aoff + m * 2048 + k * 1024); } while (0)
#define PG8_LDB(dst, b, h) do { _Pragma("unroll") for (int n = 0; n < 2; ++n) _Pragma("unroll") for (int k = 0; k < 2; ++k) dst[n][k] = *(const PG8_LAS bf16x8*)(lds + PG8_SB(b, h) + boff + n * 2048 + k * 1024); } while (0)
#define PG8_MMA(ai, bj, At, Bt) do { __builtin_amdgcn_s_setprio(1); _Pragma("unroll") for (int m = 0; m < 4; ++m) _Pragma("unroll") for (int n = 0; n < 2; ++n) _Pragma("unroll") for (int k = 0; k < 2; ++k) \
        acc[ai][bj][m][n] = __builtin_amdgcn_mfma_f32_16x16x32_bf16(Bt[n][k], At[m][k], acc[ai][bj][m][n], 0, 0, 0); __builtin_amdgcn_s_setprio(0); } while (0)
#define PG8_WAIT_V(n) asm volatile("s_waitcnt vmcnt(" #n ")" ::: "memory")
#define PG8_WAIT_L(n) asm volatile("s_waitcnt lgkmcnt(" #n ")" ::: "memory")
#define PG8_BAR __builtin_amdgcn_s_barrier()
#define PG8_SCHED __builtin_amdgcn_sched_barrier(0)
    Unit cur, nxt; int ui = 0;
    if (!S.next(0, cur)) return;
    f32x4 acc[2][2][4][2];
#pragma unroll
    for (int a = 0; a < 2; ++a)
#pragma unroll
        for (int b = 0; b < 2; ++b)
#pragma unroll
            for (int m = 0; m < 4; ++m)
#pragma unroll
                for (int n = 0; n < 2; ++n) acc[a][b][m][n] = (f32x4){0.f, 0.f, 0.f, 0.f};
    bf16x8 At[4][2], B0[2][2], B1[2][2];
    const char* cA = (const char*)g.A + (size_t)cur.pm * tstep; const char* cB = (const char*)g.Bt + (size_t)cur.pn * tstep;
    S.a_ready(cur);
    if constexpr (SP2) {
        PG8_STAGE(PG8_SB(0, 0), cB, voffB); PG8_STAGE(PG8_SB(0, 1), cB + hstep, voffB); PG8_STAGE(PG8_SA(0, 0), cA, voffA); PG8_STAGE(PG8_SA(0, 1), cA + hstep, voffA);
        if (wr == 1) PG8_BAR;
        PG8_WAIT_V(2); PG8_BAR;
        PG8_STAGE(PG8_SB(1, 0), cB + kstep, voffB); PG8_STAGE(PG8_SA(1, 0), cA + kstep, voffA); PG8_STAGE(PG8_SB(1, 1), cB + hstep + kstep, voffB);
        PG8_WAIT_V(6); PG8_BAR;
    } else {
        PG8_STAGE(PG8_SB(0, 0), cB, voffB); PG8_STAGE(PG8_SA(0, 0), cA, voffA); PG8_STAGE(PG8_SB(0, 1), cB + hstep, voffB); PG8_STAGE(PG8_SA(0, 1), cA + hstep, voffA);
        if (wr == 1) PG8_BAR;
        PG8_WAIT_V(4); PG8_BAR;
        PG8_STAGE(PG8_SB(1, 0), cB + kstep, voffB); PG8_STAGE(PG8_SA(1, 0), cA + kstep, voffA); PG8_STAGE(PG8_SB(1, 1), cB + hstep + kstep, voffB);
        PG8_WAIT_V(6); PG8_BAR;
    }
    for (;;) {
        const bool has_next = S.next(ui + 1, nxt);
        const char* nA = has_next ? (const char*)g.A + (size_t)nxt.pm * tstep : cA; const char* nB = has_next ? (const char*)g.Bt + (size_t)nxt.pn * tstep : cB;
        for (int t = 0; t < nt; t += 2) {
            const bool last = (t == nt - 2);
            const char* a1 = cA + (size_t)(t + 1) * kstep;
            const char* a2 = last ? nA : cA + (size_t)(t + 2) * kstep; const char* b2 = last ? nB : cB + (size_t)(t + 2) * kstep;
            const char* a3 = a2 + kstep; const char* b3 = b2 + kstep;
            if (last && has_next) S.a_ready(nxt);
            if constexpr (SP2) {
            PG8_LDB(B0, 0, 0); PG8_LDB(B1, 0, 1); PG8_SCHED; PG8_LDA(At, 0, 0); PG8_STAGE(PG8_SA(1, 1), a1 + hstep, voffA);
            PG8_WAIT_V(8); PG8_WAIT_L(0); PG8_BAR; PG8_MMA(0, 0, At, B0); PG8_MMA(0, 1, At, B1); PG8_BAR; PG8_SCHED;
            PG8_LDA(At, 0, 1); PG8_STAGE(PG8_SB(0, 0), b2, voffB); PG8_STAGE(PG8_SB(0, 1), b2 + hstep, voffB); PG8_STAGE(PG8_SA(0, 0), a2, voffA);
            PG8_WAIT_V(8); PG8_WAIT_L(0); PG8_BAR; PG8_MMA(1, 0, At, B0); PG8_MMA(1, 1, At, B1); PG8_BAR; PG8_SCHED;
            PG8_LDB(B0, 1, 0); PG8_LDB(B1, 1, 1); PG8_SCHED; PG8_LDA(At, 1, 0); PG8_STAGE(PG8_SA(0, 1), a2 + hstep, voffA);
            PG8_WAIT_V(8); PG8_WAIT_L(0); PG8_BAR; PG8_MMA(0, 0, At, B0); PG8_MMA(0, 1, At, B1); PG8_BAR; PG8_SCHED;
            PG8_LDA(At, 1, 1); PG8_STAGE(PG8_SB(1, 0), b3, voffB); PG8_STAGE(PG8_SB(1, 1), b3 + hstep, voffB); PG8_STAGE(PG8_SA(1, 0), a3, voffA);
            PG8_WAIT_V(8); PG8_WAIT_L(0); PG8_BAR; PG8_MMA(1, 0, At, B0); PG8_MMA(1, 1, At, B1); PG8_BAR; PG8_SCHED;
            } else {
            PG8_LDB(B0, 0, 0); PG8_SCHED; PG8_LDA(At, 0, 0); PG8_STAGE(PG8_SA(1, 1), a1 + hstep, voffA);
            PG8_WAIT_L(8); PG8_BAR; PG8_WAIT_L(0); PG8_MMA(0, 0, At, B0); PG8_BAR; PG8_SCHED;
            PG8_LDB(B1, 0, 1); PG8_STAGE(PG8_SB(0, 0), b2, voffB);
            PG8_BAR; PG8_WAIT_L(0); PG8_MMA(0, 1, At, B1); PG8_BAR;
            PG8_LDA(At, 0, 1); PG8_STAGE(PG8_SA(0, 0), a2, voffA);
            PG8_BAR; PG8_WAIT_L(0); PG8_MMA(1, 0, At, B0); PG8_BAR; PG8_SCHED;
            PG8_STAGE(PG8_SB(0, 1), b2 + hstep, voffB);
            PG8_WAIT_V(6); PG8_BAR; PG8_MMA(1, 1, At, B1); PG8_BAR;
            PG8_LDB(B0, 1, 0); PG8_SCHED; PG8_LDA(At, 1, 0); PG8_STAGE(PG8_SA(0, 1), a2 + hstep, voffA);
            PG8_WAIT_L(8); PG8_BAR; PG8_WAIT_L(0); PG8_MMA(0, 0, At, B0); PG8_BAR; PG8_SCHED;
            PG8_LDB(B1, 1, 1); PG8_STAGE(PG8_SB(1, 0), b3, voffB);
            PG8_BAR; PG8_WAIT_L(0); PG8_MMA(0, 1, At, B1); PG8_BAR;
            PG8_LDA(At, 1, 1); PG8_STAGE(PG8_SA(1, 0), a3, voffA);
            PG8_BAR; PG8_WAIT_L(0); PG8_MMA(1, 0, At, B0); PG8_BAR; PG8_SCHED;
            PG8_STAGE(PG8_SB(1, 1), b3 + hstep, voffB);
            PG8_WAIT_V(6); PG8_BAR; PG8_MMA(1, 1, At, B1); PG8_BAR;
            }
        }
        if constexpr (ALIGN_EPI) { if (wr == 0) PG8_BAR; }
        if constexpr (!Epi::AFTER_DRAIN) { E(acc, cur, wr, wc, fr, fq); S.done(cur); }
        if (!has_next) break;
#pragma unroll
        for (int a = 0; a < 2; ++a)
#pragma unroll
            for (int b = 0; b < 2; ++b)
#pragma unroll
                for (int m = 0; m < 4; ++m)
#pragma unroll
                    for (int n = 0; n < 2; ++n) acc[a][b][m][n] = (f32x4){0.f, 0.f, 0.f, 0.f};
        cur = nxt; cA = nA; cB = nB; ++ui;
        if constexpr (ALIGN_EPI) { if (wr == 1) PG8_BAR; }
    }
    PG8_WAIT_V(0);
    if constexpr (!ALIGN_EPI) { if (wr == 0) PG8_BAR; }
    PG8_BAR;
    if constexpr (Epi::AFTER_DRAIN) { E.fused(acc, cur, wr, wc, fr, fq, lds, wid, lane); S.done(cur); }
#undef PG8_SA
#undef PG8_SB
#undef PG8_STAGE
#undef PG8_LDA
#undef PG8_LDB
#undef PG8_MMA
#undef PG8_WAIT_V
#undef PG8_WAIT_L
#undef PG8_BAR
#undef PG8_SCHED
}
}

using pg8::bf16_t; using pg8::bf16x8; using pg8::f32x4; using pg8::u32x4;
typedef float f32x16 __attribute__((ext_vector_type(16)));
typedef unsigned u32x2 __attribute__((ext_vector_type(2)));
#define LAS __attribute__((address_space(3)))
#define DI __device__ __forceinline__
#define MFMA32(a, b, c) __builtin_amdgcn_mfma_f32_32x32x16_bf16((a), (b), (c), 0, 0, 0)

constexpr int DM = 1024, MP = 65536, MS = 128, MT = MP + MS, SEQ = 2048, NBATCH = 32, DEPTH = 2;
constexpr int NIN = 3200, NINP = 3328, DFF = 4096, PP = NINP;
constexpr int C_Q = 0, C_K = 384, C_V = 768, C_U = 1152, C_VB = 1408, C_QC = 1664, C_FC = 2048, C_IC = 2432, C_GC = 2816;
constexpr float ALPHA = 1.41421356237309515f;
constexpr float QSCALE = 0.125f * 1.4426950408889634f;
constexpr int SKV = 1056;
constexpr int NTHR = 512, NWAVE = 8;

constexpr size_t MiB = 1u << 20;
constexpr size_t WS_CTL = 0, CTL_BYTES = 1 * MiB;
constexpr size_t WS_WIN = 2 * MiB, WIN_L = (size_t)NINP * DM * 2;
constexpr size_t WS_WOUT = 16 * MiB, WOUT_L = (size_t)DM * DM * 2;
constexpr size_t WS_WFF1 = 20 * MiB, WFF_L = (size_t)DFF * DM * 2;
constexpr size_t WS_WFF2 = 36 * MiB;
constexpr size_t WS_XB = 52 * MiB;
constexpr size_t WS_P = 181 * MiB;
constexpr size_t WS_VT = 598 * MiB;
constexpr size_t WS_MIX = 660 * MiB;
constexpr size_t WS_HDN = WS_P;
constexpr size_t WS_KS = 789 * MiB, KS_L = (size_t)8 * SKV * 384 * 2;
constexpr size_t WS_VTS = 803 * MiB, VTS_L = (size_t)8 * 6 * 64 * SKV * 2;
constexpr size_t WS_END = 817 * MiB;
static_assert(WS_XB + (size_t)MT * DM * 2 <= WS_P && WS_P + (size_t)MT * PP * 2 <= WS_VT && WS_VT + (size_t)MP * 384 * 2 <= WS_MIX, "ws map");
static_assert(WS_MIX + (size_t)MT * DM * 2 <= WS_KS && WS_HDN + (size_t)MT * DFF * 2 <= WS_KS && WS_KS + 2 * KS_L <= WS_VTS && WS_VTS + 2 * VTS_L <= WS_END, "ws map");

constexpr size_t O_Y = 0, O_KP = 67239936, O_VP = 117571584, O_HP = 167903232, O_KS = 169476096, O_VS = 169574400, O_HS = 169672704, O_MV = 170065920;

constexpr int LDS_RING = 131072, LDS_BYTES = LDS_RING + 256;

DI unsigned cvt_pk(float lo, float hi) { typedef float f2 __attribute__((ext_vector_type(2))); typedef __bf16 b2 __attribute__((ext_vector_type(2))); f2 v = {lo, hi}; b2 b = __builtin_convertvector(v, b2); return __builtin_bit_cast(unsigned, b); }
DI bf16_t f2bf(float f) { return (bf16_t)(cvt_pk(f, 0.f) & 0xffffu); }
DI float bf2f(bf16_t b) { return __uint_as_float((unsigned)b << 16); }
DI float wave_sum(float v) {
#pragma unroll
    for (int o = 1; o < 64; o <<= 1) v += __shfl_xor(v, o);
    return v;
}
DI int crow(int r, int hi) { return (r & 3) + 8 * (r >> 2) + 4 * hi; }
DI float fexp2(float x) { return __builtin_amdgcn_exp2f(x); }
DI float flog2(float x) { return __builtin_amdgcn_logf(x); }

DI int ltid() { int t = threadIdx.x; asm volatile("" : "+v"(t)); return t; }
DI int lbid() { int b = blockIdx.x; asm volatile("" : "+s"(b)); return b; }
DI int lgdim() { int b = gridDim.x; asm volatile("" : "+s"(b)); return b; }
struct Params { const float* in[19]; float* out; unsigned char* ws; };
typedef const __attribute__((address_space(4))) Params* KP;
DI Params load_params(KP k) { Params p;
#pragma unroll
    for (int i = 0; i < 19; ++i) p.in[i] = k->in[i];
    p.out = k->out; p.ws = k->ws; return p; }
DI KP kargs() { KP k = (KP)__builtin_amdgcn_kernarg_segment_ptr(); asm volatile("" : "+s"(k)); return k; }

struct EpiG1 {
    static constexpr bool PERM = true, AFTER_DRAIN = false;
    bf16_t* P; float* outK; float* outV; bf16_t* Vt;
    __device__ __forceinline__ void operator()(const f32x4 (&acc)[2][2][4][2], const pg8::Unit& u, int wr, int wc, int fr, int fq) const {
        const int row0 = u.pm * 256 + wr * 64 + fr;
#pragma unroll
        for (int bj = 0; bj < 2; ++bj) {
            const int colh = u.pn * 256 + bj * 128;
            if (colh >= NIN) continue;
            const int col0 = colh + wc * 32 + 8 * fq;
            const float sc = colh < C_K ? QSCALE : 1.f;
#pragma unroll
            for (int ai = 0; ai < 2; ++ai)
#pragma unroll
                for (int m = 0; m < 4; ++m) {
                    const int row = row0 + ai * 128 + m * 16;
                    const f32x4 v0 = acc[ai][bj][m][0], v1 = acc[ai][bj][m][1];
                    u32x4 w; w.x = cvt_pk(v0[0] * sc, v0[1] * sc); w.y = cvt_pk(v0[2] * sc, v0[3] * sc); w.z = cvt_pk(v1[0] * sc, v1[1] * sc); w.w = cvt_pk(v1[2] * sc, v1[3] * sc);
                    *(u32x4*)(P + (size_t)row * PP + col0) = w;
                    if (colh >= C_K && colh < C_V) {
                        float* o = outK + (size_t)row * 384 + (col0 - C_K); *(f32x4*)o = v0; *(f32x4*)(o + 4) = v1;
                    } else if (colh >= C_V && colh < C_U) {
                        float* o = outV + (size_t)row * 384 + (col0 - C_V); *(f32x4*)o = v0; *(f32x4*)(o + 4) = v1;
                        const int b = row >> 11, s = row & 2047, hd = col0 - C_V;
                        bf16_t* vt = Vt + ((size_t)b * 384 + hd) * SEQ + s;
                        vt[0 * SEQ] = (bf16_t)(w.x & 0xffffu); vt[1 * SEQ] = (bf16_t)(w.x >> 16); vt[2 * SEQ] = (bf16_t)(w.y & 0xffffu); vt[3 * SEQ] = (bf16_t)(w.y >> 16);
                        vt[4 * SEQ] = (bf16_t)(w.z & 0xffffu); vt[5 * SEQ] = (bf16_t)(w.z >> 16); vt[6 * SEQ] = (bf16_t)(w.w & 0xffffu); vt[7 * SEQ] = (bf16_t)(w.w >> 16);
                    }
                }
        }
    }
};
struct EpiRelu2 {
    static constexpr bool PERM = true, AFTER_DRAIN = false;
    bf16_t* O;
    __device__ __forceinline__ void operator()(const f32x4 (&acc)[2][2][4][2], const pg8::Unit& u, int wr, int wc, int fr, int fq) const {
        const int row0 = u.pm * 256 + wr * 64 + fr, col0 = u.pn * 256 + wc * 32 + 8 * fq;
#pragma unroll
        for (int ai = 0; ai < 2; ++ai)
#pragma unroll
            for (int m = 0; m < 4; ++m) {
                bf16_t* rowp = O + (size_t)(row0 + ai * 128 + m * 16) * DFF + col0;
#pragma unroll
                for (int bj = 0; bj < 2; ++bj) {
                    f32x4 v0 = acc[ai][bj][m][0], v1 = acc[ai][bj][m][1];
#pragma unroll
                    for (int j = 0; j < 4; ++j) { const float a = fmaxf(v0[j], 0.f), b = fmaxf(v1[j], 0.f); v0[j] = a * a; v1[j] = b * b; }
                    u32x4 w; w.x = cvt_pk(v0[0], v0[1]); w.y = cvt_pk(v0[2], v0[3]); w.z = cvt_pk(v1[0], v1[1]); w.w = cvt_pk(v1[2], v1[3]);
                    *(u32x4*)(rowp + bj * 128) = w;
                }
            }
    }
};
struct EpiRes {
    static constexpr bool PERM = false, AFTER_DRAIN = false;
    const float* res; float* Y;
    __device__ __forceinline__ void operator()(const f32x4 (&acc)[2][2][4][2], const pg8::Unit& u, int wr, int wc, int fr, int fq) const {
        const int row0 = u.pm * 256 + wr * 64 + fr, col0 = u.pn * 256 + wc * 32 + 4 * fq;
#pragma unroll
        for (int ai = 0; ai < 2; ++ai)
#pragma unroll
            for (int m = 0; m < 4; ++m) {
                const size_t off = (size_t)(row0 + ai * 128 + m * 16) * DM + col0;
#pragma unroll
                for (int bj = 0; bj < 2; ++bj)
#pragma unroll
                    for (int n = 0; n < 2; ++n) {
                        const f32x4 r = *(const f32x4*)(res + off + bj * 128 + n * 16);
                        *(f32x4*)(Y + off + bj * 128 + n * 16) = r * ALPHA + acc[ai][bj][m][n];
                    }
            }
    }
};

template <class F> DI void small_gemm(LAS unsigned char* lds, const bf16_t* A, const bf16_t* Bt, int K, int N, const F& epi) {
    const int tid = ltid(), lane = tid & 63, wave = tid >> 6, n32 = lane & 31, hi = lane >> 5;
    const int nunits = 4 * (N / 32), kw = K / 8; const int bid = lbid(), gdim = lgdim();
    LAS float* red = (LAS float*)lds;
    for (int u = bid; u < nunits; u += gdim) {
        const int mt = u & 3, nt = u >> 2;
        const bf16_t* ap = A + (size_t)(32 * mt + n32) * K + wave * kw + 8 * hi;
        const bf16_t* bp = Bt + (size_t)(32 * nt + n32) * K + wave * kw + 8 * hi;
        f32x16 acc;
#pragma unroll
        for (int r = 0; r < 16; ++r) acc[r] = 0.f;
#pragma unroll 8
        for (int kk = 0; kk < kw; kk += 16) acc = MFMA32(*(const bf16x8*)(ap + kk), *(const bf16x8*)(bp + kk), acc);
#pragma unroll
        for (int r = 0; r < 16; ++r) red[(wave * 32 + crow(r, hi)) * 33 + n32] = acc[r];
        __syncthreads();
        const int row = tid >> 4, c0 = (tid & 15) * 2;
        float v0 = 0.f, v1 = 0.f;
#pragma unroll
        for (int w = 0; w < 8; ++w) { v0 += red[(w * 32 + row) * 33 + c0]; v1 += red[(w * 32 + row) * 33 + c0 + 1]; }
        epi(32 * mt + row, 32 * nt + c0, v0, v1);
        __syncthreads();
    }
}

DI void transpose_item(const float* W, int K, int N, bf16_t* WT, LAS float* scr, int item, int lane) {
    const int nblk = N / 32, kb = item / nblk, nb = item % nblk, k0 = 64 * kb, n0 = 32 * nb;
#pragma unroll 8
    for (int i = 0; i < 32; ++i) { const int kk = 2 * i + (lane >> 5); scr[kk * 33 + (lane & 31)] = W[(size_t)(k0 + kk) * N + n0 + (lane & 31)]; }
    __builtin_amdgcn_s_waitcnt(0); asm volatile("" ::: "memory");
    const int c = lane & 7;
#pragma unroll
    for (int j = 0; j < 4; ++j) { const int n = (lane >> 3) + 8 * j; const LAS float* s = scr + (8 * c) * 33 + n;
        u32x4 o; o.x = cvt_pk(s[0 * 33], s[1 * 33]); o.y = cvt_pk(s[2 * 33], s[3 * 33]); o.z = cvt_pk(s[4 * 33], s[5 * 33]); o.w = cvt_pk(s[6 * 33], s[7 * 33]);
        *(u32x4*)(WT + (size_t)(n0 + n) * K + k0 + 8 * c) = o; }
    __builtin_amdgcn_s_waitcnt(0); asm volatile("" ::: "memory");
}

DI void prologue(LAS unsigned char* lds) {
    const Params p = load_params(kargs());
    const int tid = ltid(), lane = tid & 63, wave = tid >> 6; const int bid = lbid(), gdim = lgdim();
    const int gw = bid * NWAVE + wave, ngw = gdim * NWAVE;
    LAS float* scr = (LAS float*)(lds + wave * 16384);
    constexpr int I_IN = (DM / 64) * (NIN / 32), I_OUT = (DM / 64) * (DM / 32), I_F1 = (DM / 64) * (DFF / 32), I_F2 = (DFF / 64) * (DM / 32), I_L = I_IN + I_OUT + I_F1 + I_F2;
    for (int it = gw; it < DEPTH * I_L; it += ngw) {
        const int l = it / I_L; int r = it % I_L;
        if (r < I_IN) { transpose_item(p.in[5] + (size_t)l * DM * NIN, DM, NIN, (bf16_t*)(p.ws + WS_WIN + l * WIN_L), scr, r, lane); continue; } r -= I_IN;
        if (r < I_OUT) { transpose_item(p.in[6] + (size_t)l * DM * DM, DM, DM, (bf16_t*)(p.ws + WS_WOUT + l * WOUT_L), scr, r, lane); continue; } r -= I_OUT;
        if (r < I_F1) { transpose_item(p.in[15] + (size_t)l * DM * DFF, DM, DFF, (bf16_t*)(p.ws + WS_WFF1 + l * WFF_L), scr, r, lane); continue; } r -= I_F1;
        transpose_item(p.in[16] + (size_t)l * DFF * DM, DFF, DM, (bf16_t*)(p.ws + WS_WFF2 + l * WFF_L), scr, r, lane);
    }
    const size_t gt = (size_t)bid * NTHR + tid, ngt = (size_t)gdim * NTHR;
    for (size_t i = gt; i < (size_t)DEPTH * 128 * DM / 8; i += ngt) {
        const size_t l = i / (128 * DM / 8), r = i % (128 * DM / 8);
        *(u32x4*)((bf16_t*)(p.ws + WS_WIN + l * WIN_L) + (size_t)NIN * DM + r * 8) = (u32x4){0u, 0u, 0u, 0u};
    }
    bf16_t* XB = (bf16_t*)(p.ws + WS_XB);
    for (size_t i = gt; i < (size_t)MT * DM / 8; i += ngt) {
        const size_t row = i >> 7, c8 = (i & 127) * 8;
        const float* src = row < MP ? p.in[0] + row * DM + c8 : p.in[1] + (row - MP) * DM + c8;
        const f32x4 a = *(const f32x4*)src, b = *(const f32x4*)(src + 4);
        u32x4 o; o.x = cvt_pk(a[0], a[1]); o.y = cvt_pk(a[2], a[3]); o.z = cvt_pk(b[0], b[1]); o.w = cvt_pk(b[2], b[3]);
        *(u32x4*)(XB + row * DM + c8) = o;
    }
    for (size_t i = gt; i < (size_t)DEPTH * 8 * SKV * 384 / 8; i += ngt) {
        const size_t c8 = (i % 48) * 8, s = (i / 48) % SKV, lb = i / (48 * SKV);
        if (s >= 1024 && s < 1040) continue;
        u32x4 o = (u32x4){0u, 0u, 0u, 0u};
        if (s < 1024) { const float* src = p.in[2] + (lb * 1024 + s) * 384 + c8; const f32x4 a = *(const f32x4*)src, b = *(const f32x4*)(src + 4);
            o.x = cvt_pk(a[0], a[1]); o.y = cvt_pk(a[2], a[3]); o.z = cvt_pk(b[0], b[1]); o.w = cvt_pk(b[2], b[3]); }
        *(u32x4*)((bf16_t*)(p.ws + WS_KS) + (lb * SKV + s) * 384 + c8) = o;
    }
    for (size_t i = gt; i < (size_t)DEPTH * 8 * (SKV / 8) * 384; i += ngt) {
        const size_t hd = i % 384, s8 = (i / 384) % (SKV / 8), lb = i / (384 * (SKV / 8));
        const size_t s0 = s8 * 8;
        if (s0 >= 1024 && s0 < 1040) continue;
        u32x4 o = (u32x4){0u, 0u, 0u, 0u};
        if (s0 < 1024) { const float* src = p.in[3] + (lb * 1024 + s0) * 384 + hd;
            o.x = cvt_pk(src[0], src[384]); o.y = cvt_pk(src[2 * 384], src[3 * 384]); o.z = cvt_pk(src[4 * 384], src[5 * 384]); o.w = cvt_pk(src[6 * 384], src[7 * 384]); }
        *(u32x4*)((bf16_t*)(p.ws + WS_VTS) + (lb * 384 + hd) * SKV + s0) = o;
    }
}

DI void attn_wave_unit(const bf16_t* Q, int qpitch, int nvalid, int qpos0, const bf16_t* Kb, int kpitch, const bf16_t* Vt, int vpitch, int ntiles,
                       bf16_t* O, int opitch, int lane) {
    const int t = lane & 31, hi = lane >> 5;
    const int tq = t < nvalid ? t : nvalid - 1;
    bf16x8 qf[4];
#pragma unroll
    for (int ks = 0; ks < 4; ++ks) qf[ks] = *(const bf16x8*)(Q + (size_t)tq * qpitch + 16 * ks + 8 * hi);
    const int tpos = qpos0 + t;
    const int koff = (t & 16) | ((t & 4) << 1) | ((t & 8) >> 1) | (t & 3);
    const bf16_t* kp = Kb + (size_t)koff * kpitch + 8 * hi;
    const bf16_t* vp = Vt + (size_t)t * vpitch + 8 * hi;
    f32x16 o0, o1;
#pragma unroll
    for (int r = 0; r < 16; ++r) { o0[r] = 0.f; o1[r] = 0.f; }
    float R = 0.f;
    bf16x8 kf[4], vf[2][2], kn[4], vn[2][2];
    {
        const int s0 = (ntiles - 1) * 32;
#pragma unroll
        for (int ks = 0; ks < 4; ++ks) kf[ks] = *(const bf16x8*)(kp + (size_t)s0 * kpitch + 16 * ks);
#pragma unroll
        for (int dd = 0; dd < 2; ++dd)
#pragma unroll
            for (int m = 0; m < 2; ++m) vf[dd][m] = *(const bf16x8*)(vp + (size_t)(32 * dd) * vpitch + s0 + 16 * m);
    }
    for (int kt = ntiles - 1; kt >= 0; --kt) {
        const int s0 = kt * 32;
        {
            const int sn = kt > 0 ? s0 - 32 : 0;
#pragma unroll
            for (int ks = 0; ks < 4; ++ks) kn[ks] = *(const bf16x8*)(kp + (size_t)sn * kpitch + 16 * ks);
#pragma unroll
            for (int dd = 0; dd < 2; ++dd)
#pragma unroll
                for (int m = 0; m < 2; ++m) vn[dd][m] = *(const bf16x8*)(vp + (size_t)(32 * dd) * vpitch + sn + 16 * m);
        }
        f32x16 c;
#pragma unroll
        for (int r = 0; r < 16; ++r) c[r] = 0.f;
#pragma unroll
        for (int ks = 0; ks < 4; ++ks) c = MFMA32(kf[ks], qf[ks], c);
        const bool diag = (s0 + 31 >= qpos0);
        float L[16];
#pragma unroll
        for (int r = 0; r < 16; ++r) { const float z = c[r]; const float e = fexp2(-fabsf(z)); L[r] = -(fmaxf(z, 0.f) + flog2(1.f + e)); }
        if (diag) {
#pragma unroll
            for (int r = 0; r < 16; ++r) { const int key = s0 + 16 * (r >> 3) + 8 * hi + (r & 7); if (key >= tpos) L[r] = 0.f; }
        }
        float a1 = 0.f, a0 = 0.f;
#pragma unroll
        for (int r = 15; r >= 8; --r) { a1 += L[r]; L[r] = a1; }
#pragma unroll
        for (int r = 7; r >= 0; --r) { a0 += L[r]; L[r] = a0; }
        const float g0p = __shfl_xor(a0, 32), g1p = __shfl_xor(a1, 32);
        const float off1 = R + (hi ? 0.f : g1p);
        const float off0 = R + a1 + g1p + (hi ? 0.f : g0p);
        R += (a0 + a1) + (g0p + g1p);
        float w[16];
#pragma unroll
        for (int r = 0; r < 16; ++r) w[r] = fexp2(c[r] + L[r] + (r < 8 ? off0 : off1));
        if (diag) {
#pragma unroll
            for (int r = 0; r < 16; ++r) { const int key = s0 + 16 * (r >> 3) + 8 * hi + (r & 7); if (key >= tpos) w[r] = 0.f; }
        }
        u32x4 p0, p1;
        p0.x = cvt_pk(w[0], w[1]); p0.y = cvt_pk(w[2], w[3]); p0.z = cvt_pk(w[4], w[5]); p0.w = cvt_pk(w[6], w[7]);
        p1.x = cvt_pk(w[8], w[9]); p1.y = cvt_pk(w[10], w[11]); p1.z = cvt_pk(w[12], w[13]); p1.w = cvt_pk(w[14], w[15]);
        const bf16x8 wb0 = __builtin_bit_cast(bf16x8, p0), wb1 = __builtin_bit_cast(bf16x8, p1);
        o0 = MFMA32(vf[0][0], wb0, o0); o0 = MFMA32(vf[0][1], wb1, o0);
        o1 = MFMA32(vf[1][0], wb0, o1); o1 = MFMA32(vf[1][1], wb1, o1);
        if (__all(R < -160.f)) break;
#pragma unroll
        for (int ks = 0; ks < 4; ++ks) kf[ks] = kn[ks];
#pragma unroll
        for (int dd = 0; dd < 2; ++dd)
#pragma unroll
            for (int m = 0; m < 2; ++m) vf[dd][m] = vn[dd][m];
    }
    if (t < nvalid) {
#pragma unroll
        for (int g = 0; g < 4; ++g) {
            u32x2 a; a.x = cvt_pk(o0[4 * g], o0[4 * g + 1]); a.y = cvt_pk(o0[4 * g + 2], o0[4 * g + 3]);
            u32x2 b; b.x = cvt_pk(o1[4 * g], o1[4 * g + 1]); b.y = cvt_pk(o1[4 * g + 2], o1[4 * g + 3]);
            *(u32x2*)(O + (size_t)t * opitch + 8 * g + 4 * hi) = a;
            *(u32x2*)(O + (size_t)t * opitch + 32 + 8 * g + 4 * hi) = b;
        }
    }
}

DI void gmlp_unit(LAS unsigned char* lds, const bf16_t* Prow0, int ntok, bf16_t* mixrow0, float* vn_out,
                  const float* lng, const float* lnb, const float* ws, const float* bs) {
    constexpr int VP = 136;
    LAS bf16_t* vnT = (LAS bf16_t*)lds;
    const int tid = ltid(), lane = tid & 63, wave = tid >> 6;
    const f32x4 gg = *(const f32x4*)(lng + 4 * lane), bb = *(const f32x4*)(lnb + 4 * lane);
    for (int t = wave; t < 128; t += 8) {
        f32x4 vn = (f32x4){0.f, 0.f, 0.f, 0.f};
        if (t < ntok) {
            const u32x2 raw = *(const u32x2*)(Prow0 + (size_t)t * PP + C_VB + 4 * lane);
            f32x4 v; v[0] = __uint_as_float(raw.x << 16); v[1] = __uint_as_float(raw.x & 0xffff0000u); v[2] = __uint_as_float(raw.y << 16); v[3] = __uint_as_float(raw.y & 0xffff0000u);
            const float mean = wave_sum((v[0] + v[1]) + (v[2] + v[3])) * (1.f / 256.f);
            v = v - mean;
            const float var = wave_sum((v[0] * v[0] + v[1] * v[1]) + (v[2] * v[2] + v[3] * v[3])) * (1.f / 256.f);
            const float rstd = 1.0f / sqrtf(var + 1e-5f);
            vn = v * rstd * gg + bb;
            if (vn_out) *(f32x4*)(vn_out + (size_t)t * 256 + 4 * lane) = vn;
        }
#pragma unroll
        for (int j = 0; j < 4; ++j) vnT[(4 * lane + j) * VP + t] = f2bf(vn[j]);
    }
    __syncthreads();
    const int n = lane & 31, hi = lane >> 5, c = 32 * wave + n, g = wave >> 1;
    const int nmt = (ntok + 31) / 32;
    for (int mt = 0; mt < nmt; ++mt) {
        f32x16 acc;
#pragma unroll
        for (int r = 0; r < 16; ++r) acc[r] = 0.f;
        const int trow = 32 * mt + n;
        for (int ks = 0; ks < 2 * (mt + 1); ++ks) {
            const int sb = 16 * ks + 8 * hi;
            const float* wp = ws + ((size_t)g * 128 + trow) * 128 + sb;
            f32x4 w0 = *(const f32x4*)wp, w1 = *(const f32x4*)(wp + 4);
#pragma unroll
            for (int j = 0; j < 4; ++j) { if (sb + j > trow) w0[j] = 0.f; if (sb + 4 + j > trow) w1[j] = 0.f; }
            u32x4 pa; pa.x = cvt_pk(w0[0], w0[1]); pa.y = cvt_pk(w0[2], w0[3]); pa.z = cvt_pk(w1[0], w1[1]); pa.w = cvt_pk(w1[2], w1[3]);
            const bf16x8 b = *(const LAS bf16x8*)(vnT + c * VP + sb);
            acc = MFMA32(__builtin_bit_cast(bf16x8, pa), b, acc);
        }
#pragma unroll
        for (int r = 0; r < 16; ++r) {
            const int t = 32 * mt + crow(r, hi);
            if (t < ntok) {
                const float uval = bf2f(Prow0[(size_t)t * PP + C_U + c]);
                mixrow0[(size_t)t * DM + 384 + c] = f2bf(uval * (acc[r] + bs[g * 128 + t]));
            }
        }
    }
    __syncthreads();
}

constexpr float LOG2E = 1.4426950408889634f;
DI void hgrn_unit(LAS unsigned char* lds, const bf16_t* Prow0, int ntok, int h, int layer, const float* S0, float* Sout, bf16_t* mixrow0,
                  const float* lb_logits, const float* normw) {
    const int tid = ltid(), lane = tid & 63, w = tid >> 6, n = lane & 31, hi = lane >> 5;
    LAS bf16_t* qt_ = (LAS bf16_t*)lds; LAS bf16_t* kt_ = qt_ + 2304; LAS bf16_t* qh_ = kt_ + 2304; LAS bf16_t* gw_ = qh_ + 2304;
    LAS bf16_t* khT_ = gw_ + 2304; LAS bf16_t* vT_ = khT_ + 2560;
    LAS float* a_ = (LAS float*)(vT_ + 2560); LAS float* gs_ = a_ + 64; LAS float* oi_ = gs_ + 512; LAS float* po_ = oi_ + 2048; LAS float* sq_ = po_ + 4096;
    const int dt = (w >> 1) & 1, et = w & 1;
    f32x16 S;
#pragma unroll
    for (int r = 0; r < 16; ++r) S[r] = (S0 && w < 4) ? S0[(32 * dt + crow(r, hi)) * 64 + 32 * et + n] : 0.f;
    float lbv = 0.f;
    if (layer > 0) { const float x0 = lb_logits[64 * h + lane], x1 = lb_logits[384 + 64 * h + lane]; lbv = 1.f / (1.f + __expf(x0 - x1)); }
    const float nwv = normw[64 * h + lane];
    const bf16_t* pc = Prow0 + 64 * h + lane;
    bf16_t rq[4], rf[4], rv[4], rg[4];
#pragma unroll
    for (int j = 0; j < 4; ++j) { const int t = 4 * w + j; const bf16_t* rp = pc + (size_t)(t < ntok ? t : 0) * PP; rq[j] = rp[C_QC]; rf[j] = rp[C_FC]; rv[j] = rp[C_IC]; rg[j] = rp[C_GC]; }
    for (int t0 = 0; t0 < ntok; t0 += 32) {
        float cs[4], kv[4], qv[4], vv[4], gv[4];
        float run = 0.f;
#pragma unroll
        for (int j = 0; j < 4; ++j) {
            const bool valid = t0 + 4 * w + j < ntok;
            const float zf = fminf(fmaxf(bf2f(rf[j]), -80.f), 80.f), zq = bf2f(rq[j]), zg = bf2f(rg[j]);
            const float em = fexp2(-zf * LOG2E), sp = __builtin_amdgcn_rcpf(1.f + em);
            float lf2 = flog2(lbv + (1.f - lbv) * sp);
            kv[j] = valid ? (1.f - lbv) * em * sp : 0.f;
            if (!valid) lf2 = 0.f;
            run += lf2; cs[j] = run;
            qv[j] = valid ? zq * __builtin_amdgcn_rcpf(1.f + fexp2(-fmaxf(zq, -80.f) * LOG2E)) : 0.f;
            vv[j] = valid ? bf2f(rv[j]) : 0.f;
            gv[j] = nwv * __builtin_amdgcn_rcpf(1.f + fexp2(-fmaxf(zg, -80.f) * LOG2E));
        }
        gs_[w * 64 + lane] = run;
        if (t0 + 32 < ntok) {
#pragma unroll
            for (int j = 0; j < 4; ++j) { const bf16_t* rp = pc + (size_t)(t0 + 32 + 4 * w + j) * PP; rq[j] = rp[C_QC]; rf[j] = rp[C_FC]; rv[j] = rp[C_IC]; rg[j] = rp[C_GC]; }
        }
        __syncthreads();
        {
            float pre = 0.f, r2 = 0.f, bl = 0.f;
#pragma unroll
            for (int ww = 0; ww < 8; ++ww) { const float g = gs_[ww * 64 + lane]; if (ww < w) pre += g; if (ww < 4) r2 += g; bl += g; }
            float kh[4], vq[4];
#pragma unroll
            for (int j = 0; j < 4; ++j) {
                const int t = 4 * w + j;
                const float b2 = pre + cs[j], d1 = b2 - r2;
                qt_[t * 72 + lane] = f2bf(qv[j] * fexp2(fminf(d1, 100.f)));
                kt_[t * 72 + lane] = f2bf(kv[j] * fexp2(fminf(-d1, 100.f)));
                qh_[t * 72 + lane] = f2bf(qv[j] * fexp2(b2));
                gw_[t * 72 + lane] = f2bf(gv[j]);
                kh[j] = kv[j] * fexp2(bl - b2); vq[j] = vv[j];
            }
            *(LAS u32x2*)(khT_ + lane * 40 + 4 * w) = (u32x2){cvt_pk(kh[0], kh[1]), cvt_pk(kh[2], kh[3])};
            *(LAS u32x2*)(vT_ + lane * 40 + 4 * w) = (u32x2){cvt_pk(vq[0], vq[1]), cvt_pk(vq[2], vq[3])};
            if (w == 0) a_[lane] = fexp2(bl);
        }
        __syncthreads();
        if (w < 4) {
            f32x16 po;
#pragma unroll
            for (int r = 0; r < 16; ++r) po[r] = 0.f;
#pragma unroll
            for (int m = 0; m < 2; ++m) {
                const LAS bf16_t* qr = qh_ + n * 72 + 32 * dt + 16 * m + 4 * hi;
                const u32x2 lo = *(const LAS u32x2*)qr, h2 = *(const LAS u32x2*)(qr + 8);
                u32x4 sp; sp.x = cvt_pk(S[8 * m], S[8 * m + 1]); sp.y = cvt_pk(S[8 * m + 2], S[8 * m + 3]); sp.z = cvt_pk(S[8 * m + 4], S[8 * m + 5]); sp.w = cvt_pk(S[8 * m + 6], S[8 * m + 7]);
                po = MFMA32(__builtin_bit_cast(bf16x8, sp), __builtin_bit_cast(bf16x8, ((u32x4){lo.x, lo.y, h2.x, h2.y})), po);
            }
#pragma unroll
            for (int r = 0; r < 16; ++r) po_[((dt * 2 + et) * 16 + r) * 64 + lane] = po[r];
#pragma unroll
            for (int g = 0; g < 4; ++g) { const f32x4 av = *(const LAS f32x4*)(a_ + 32 * dt + 8 * g + 4 * hi);
#pragma unroll
                for (int i = 0; i < 4; ++i) S[4 * g + i] *= av[i]; }
#pragma unroll
            for (int m = 0; m < 2; ++m) S = MFMA32(*(const LAS bf16x8*)(khT_ + (32 * dt + n) * 40 + 16 * m + 8 * hi), *(const LAS bf16x8*)(vT_ + (32 * et + n) * 40 + 16 * m + 8 * hi), S);
        } else if (w < 6) {
            f32x16 c;
#pragma unroll
            for (int r = 0; r < 16; ++r) c[r] = 0.f;
#pragma unroll
            for (int ks = 0; ks < 4; ++ks) c = MFMA32(*(const LAS bf16x8*)(kt_ + n * 72 + 16 * ks + 8 * hi), *(const LAS bf16x8*)(qt_ + n * 72 + 16 * ks + 8 * hi), c);
#pragma unroll
            for (int r = 0; r < 16; ++r) if (crow(r, hi) > n) c[r] = 0.f;
            u32x4 p0, p1;
            p0.x = cvt_pk(c[0], c[1]); p0.y = cvt_pk(c[2], c[3]); p0.z = cvt_pk(c[4], c[5]); p0.w = cvt_pk(c[6], c[7]);
            p1.x = cvt_pk(c[8], c[9]); p1.y = cvt_pk(c[10], c[11]); p1.z = cvt_pk(c[12], c[13]); p1.w = cvt_pk(c[14], c[15]);
            f32x16 o;
#pragma unroll
            for (int r = 0; r < 16; ++r) o[r] = 0.f;
#pragma unroll
            for (int m = 0; m < 2; ++m) {
                const LAS bf16_t* vr = vT_ + (32 * et + n) * 40 + 16 * m + 4 * hi;
                const u32x2 lo = *(const LAS u32x2*)vr, h2 = *(const LAS u32x2*)(vr + 8);
                o = MFMA32(__builtin_bit_cast(bf16x8, ((u32x4){lo.x, lo.y, h2.x, h2.y})), __builtin_bit_cast(bf16x8, m ? p1 : p0), o);
            }
#pragma unroll
            for (int r = 0; r < 16; ++r) oi_[(et * 16 + r) * 64 + lane] = o[r];
        }
        __syncthreads();
        {
            const int rq4 = w >> 1;
            float o[4]; float ss = 0.f;
#pragma unroll
            for (int i = 0; i < 4; ++i) { const int r = 4 * rq4 + i;
                o[i] = oi_[(et * 16 + r) * 64 + lane] + po_[(et * 16 + r) * 64 + lane] + po_[((2 + et) * 16 + r) * 64 + lane]; ss += o[i] * o[i]; }
            ss += __shfl_xor(ss, 32);
            if (hi == 0) sq_[w * 32 + n] = ss;
            __syncthreads();
            float tot = 0.f;
#pragma unroll
            for (int ww = 0; ww < 8; ++ww) tot += sq_[ww * 32 + n];
            const float rinv = 1.0f / sqrtf(tot * (1.f / 64.f) + 1e-6f);
            const int e0 = 32 * et + 8 * rq4 + 4 * hi;
            const u32x2 gr = *(const LAS u32x2*)(gw_ + n * 72 + e0);
            const float g0 = __uint_as_float(gr.x << 16), g1 = __uint_as_float(gr.x & 0xffff0000u), g2 = __uint_as_float(gr.y << 16), g3 = __uint_as_float(gr.y & 0xffff0000u);
            if (t0 + n < ntok) {
                u32x2 wv; wv.x = cvt_pk(o[0] * rinv * g0, o[1] * rinv * g1); wv.y = cvt_pk(o[2] * rinv * g2, o[3] * rinv * g3);
                *(u32x2*)(mixrow0 + (size_t)(t0 + n) * DM + 640 + 64 * h + e0) = wv;
            }
        }
    }
    if (w < 4) {
#pragma unroll
        for (int r = 0; r < 16; ++r) Sout[(32 * dt + crow(r, hi)) * 64 + 32 * et + n] = S[r];
    }
}

constexpr int U_HP = 192, U_AS = 6, U_AP = 1536, U_GP = 512, U_HS = 48, U_GS = 8;
constexpr int U0_AS = U_HP, U0_AP = U0_AS + U_AS, U0_GP = U0_AP + U_AP, U0_HS = U0_GP + U_GP, U0_GS = U0_HS + U_HS, U_TOTAL = U0_GS + U_GS;

DI void mix_phase(LAS unsigned char* lds, int l, int cidx) {
    const int tid = ltid(), lane = tid & 63, wave = tid >> 6;
    volatile LAS int* sU = (volatile LAS int*)(lds + LDS_RING);
    for (;;) {
        { const KP k = kargs(); if (tid == 0) *sU = (int)atomicAdd((unsigned*)(k->ws + WS_CTL) + 64 * (1 + cidx), 1u); }
        __syncthreads();
        const int u = __builtin_amdgcn_readfirstlane(*sU);
        __syncthreads();
        if (u >= U_TOTAL) break;
        const KP k = kargs();
        unsigned char* ws = k->ws;
        const bf16_t* P = (const bf16_t*)(ws + WS_P);
        bf16_t* MIXB = (bf16_t*)(ws + WS_MIX);
        if (u < U0_AS) {
            const int b = u / 6, h = u % 6;
            hgrn_unit(lds, P + (size_t)b * SEQ * PP, SEQ, h, l, nullptr, k->out + O_HP + ((size_t)(l * NBATCH + b) * 6 + h) * 4096,
                      MIXB + (size_t)b * SEQ * DM, k->in[11], k->in[12] + l * 384);
        } else if (u < U0_AP) {
            const int su = (u - U0_AS) * 8 + wave, b = su / 6, h = su % 6;
            const bf16_t* KS = (const bf16_t*)(ws + WS_KS + l * KS_L);
            const bf16_t* VTS = (const bf16_t*)(ws + WS_VTS + l * VTS_L);
            attn_wave_unit(P + (size_t)(MP + 16 * b) * PP + C_Q + 64 * h, PP, 16, 1024, KS + (size_t)b * SKV * 384 + 64 * h, 384,
                           VTS + (size_t)(b * 384 + 64 * h) * SKV, SKV, SKV / 32, MIXB + (size_t)(MP + 16 * b) * DM + 64 * h, DM, lane);
        } else if (u < U0_GP) {
            const int au = u - U0_AP, bh = au >> 3, b = bh / 6, h = bh % 6, qt = (au & 7) * 8 + wave;
            const bf16_t* Kb = P + (size_t)b * SEQ * PP + C_K + 64 * h;
            const bf16_t* Vt = (const bf16_t*)(ws + WS_VT) + (size_t)(b * 384 + 64 * h) * SEQ;
            attn_wave_unit(P + (size_t)(b * SEQ + 32 * qt) * PP + C_Q + 64 * h, PP, 32, 32 * qt, Kb, PP, Vt, SEQ, qt + 1,
                           MIXB + (size_t)(b * SEQ + 32 * qt) * DM + 64 * h, DM, lane);
        } else if (u < U0_HS) {
            const int gu = u - U0_GP;
            gmlp_unit(lds, P + (size_t)gu * 128 * PP, 128, MIXB + (size_t)gu * 128 * DM, nullptr,
                      k->in[7] + l * 256, k->in[8] + l * 256, k->in[9] + (size_t)l * 4 * 128 * 128, k->in[10] + l * 4 * 128);
        } else if (u < U0_GS) {
            const int hu = u - U0_HS, b = hu / 6, h = hu % 6;
            hgrn_unit(lds, P + (size_t)(MP + 16 * b) * PP, 16, h, l, k->in[4] + ((size_t)(l * 8 + b) * 6 + h) * 4096, k->out + O_HS + ((size_t)(l * 8 + b) * 6 + h) * 4096,
                      MIXB + (size_t)(MP + 16 * b) * DM, k->in[11], k->in[12] + l * 384);
        } else {
            const int b = u - U0_GS;
            gmlp_unit(lds, P + (size_t)(MP + 16 * b) * PP, 16, MIXB + (size_t)(MP + 16 * b) * DM, k->out + O_MV + (size_t)(l * 8 + b) * 16 * 256,
                      k->in[7] + l * 256, k->in[8] + l * 256, k->in[9] + (size_t)l * 4 * 128 * 128, k->in[10] + l * 4 * 128);
        }
    }
}

DI void ln_phase(float* Y, bf16_t* XB, const float* g, const float* b) {
    const int tid = ltid(), lane = tid & 63, wave = tid >> 6;
    const int gw = lbid() * NWAVE + wave, ngw = lgdim() * NWAVE;
    f32x4 gg[4], bb[4];
#pragma unroll
    for (int j = 0; j < 4; ++j) { gg[j] = *(const f32x4*)(g + 4 * lane + 256 * j); bb[j] = *(const f32x4*)(b + 4 * lane + 256 * j); }
    for (int row = gw; row < MT; row += ngw) {
        float* yr = Y + (size_t)row * DM + 4 * lane;
        f32x4 v[4]; float s = 0.f;
#pragma unroll
        for (int j = 0; j < 4; ++j) { v[j] = *(const f32x4*)(yr + 256 * j); s += (v[j][0] + v[j][1]) + (v[j][2] + v[j][3]); }
        const float mean = wave_sum(s) * (1.f / DM); float s2 = 0.f;
#pragma unroll
        for (int j = 0; j < 4; ++j) { v[j] = v[j] - mean; s2 += (v[j][0] * v[j][0] + v[j][1] * v[j][1]) + (v[j][2] * v[j][2] + v[j][3] * v[j][3]); }
        const float rstd = 1.0f / sqrtf(wave_sum(s2) * (1.f / DM) + 1e-5f);
#pragma unroll
        for (int j = 0; j < 4; ++j) {
            const f32x4 o = v[j] * rstd * gg[j] + bb[j];
            *(f32x4*)(yr + 256 * j) = o;
            u32x2 w; w.x = cvt_pk(o[0], o[1]); w.y = cvt_pk(o[2], o[3]);
            *(u32x2*)(XB + (size_t)row * DM + 4 * lane + 256 * j) = w;
        }
    }
}

DI void g1_phase(LAS unsigned char* lds, int l) {
    const KP pk = kargs(); float* out = pk->out; unsigned char* ws = pk->ws;
    bf16_t* XB = (bf16_t*)(ws + WS_XB); bf16_t* P = (bf16_t*)(ws + WS_P);
    const bf16_t* WinT = (const bf16_t*)(ws + WS_WIN + l * WIN_L);
    {
        pg8::Gemm g{XB, WinT, MP, NINP, DM}; pg8::StaticOrder S; S.init(MP, NINP, lgdim(), lbid());
        EpiG1 E{P, out + O_KP + (size_t)l * MP * 384, out + O_VP + (size_t)l * MP * 384, (bf16_t*)(ws + WS_VT)};
        pg8::gemm_phase<EpiG1, pg8::StaticOrder, true, true>(lds, g, S, E);
    }
    float* oks = out + O_KS + (size_t)l * MS * 384; float* ovs = out + O_VS + (size_t)l * MS * 384;
    bf16_t* KS = (bf16_t*)(ws + WS_KS + l * KS_L); bf16_t* VTS = (bf16_t*)(ws + WS_VTS + l * VTS_L);
    small_gemm(lds, XB + (size_t)MP * DM, WinT, DM, NIN, [=](int sr, int c, float v0, float v1) {
        const float sc = c < C_K ? QSCALE : 1.f;
        const unsigned pkv = cvt_pk(v0 * sc, v1 * sc);
        *(unsigned*)(P + (size_t)(MP + sr) * PP + c) = pkv;
        const int b = sr >> 4, t = sr & 15;
        if (c >= C_K && c < C_V) { oks[(size_t)sr * 384 + c - C_K] = v0; oks[(size_t)sr * 384 + c - C_K + 1] = v1;
            *(unsigned*)(KS + ((size_t)b * SKV + 1024 + t) * 384 + c - C_K) = pkv; }
        else if (c >= C_V && c < C_U) { ovs[(size_t)sr * 384 + c - C_V] = v0; ovs[(size_t)sr * 384 + c - C_V + 1] = v1;
            bf16_t* vt = VTS + ((size_t)b * 384 + (c - C_V)) * SKV + 1024 + t; vt[0] = (bf16_t)(pkv & 0xffffu); vt[SKV] = (bf16_t)(pkv >> 16); }
    });
}
DI void g2_phase(LAS unsigned char* lds, int l) {
    const KP pk = kargs(); float* Y = pk->out + O_Y; unsigned char* ws = pk->ws;
    bf16_t* MIXB = (bf16_t*)(ws + WS_MIX); const bf16_t* WoutT = (const bf16_t*)(ws + WS_WOUT + l * WOUT_L);
    {
        pg8::Gemm g{MIXB, WoutT, MP, DM, DM}; pg8::StaticOrder S; S.init(MP, DM, lgdim(), lbid());
        EpiRes E{l == 0 ? pk->in[0] : Y, Y};
        pg8::gemm_phase<EpiRes, pg8::StaticOrder, true, true>(lds, g, S, E);
    }
    const float* rs = l == 0 ? pk->in[1] : Y + (size_t)MP * DM;
    small_gemm(lds, MIXB + (size_t)MP * DM, WoutT, DM, DM, [=](int sr, int c, float v0, float v1) {
        float* y = Y + (size_t)(MP + sr) * DM + c; const float r0 = rs[(size_t)sr * DM + c], r1 = rs[(size_t)sr * DM + c + 1]; y[0] = ALPHA * r0 + v0; y[1] = ALPHA * r1 + v1; });
}
DI void g3_phase(LAS unsigned char* lds, int l) {
    const KP pk = kargs(); unsigned char* ws = pk->ws;
    bf16_t* XB = (bf16_t*)(ws + WS_XB); bf16_t* HDN = (bf16_t*)(ws + WS_HDN); const bf16_t* Wf1T = (const bf16_t*)(ws + WS_WFF1 + l * WFF_L);
    {
        pg8::Gemm g{XB, Wf1T, MP, DFF, DM}; pg8::StaticOrder S; S.init(MP, DFF, lgdim(), lbid());
        EpiRelu2 E{HDN};
        pg8::gemm_phase<EpiRelu2, pg8::StaticOrder, true, true>(lds, g, S, E);
    }
    small_gemm(lds, XB + (size_t)MP * DM, Wf1T, DM, DFF, [=](int sr, int c, float v0, float v1) {
        const float a = fmaxf(v0, 0.f), b = fmaxf(v1, 0.f); *(unsigned*)(HDN + (size_t)(MP + sr) * DFF + c) = cvt_pk(a * a, b * b); });
}
DI void g4_phase(LAS unsigned char* lds, int l) {
    const KP pk = kargs(); float* Y = pk->out + O_Y; unsigned char* ws = pk->ws;
    bf16_t* HDN = (bf16_t*)(ws + WS_HDN); const bf16_t* Wf2T = (const bf16_t*)(ws + WS_WFF2 + l * WFF_L);
    {
        pg8::Gemm g{HDN, Wf2T, MP, DM, DFF}; pg8::StaticOrder S; S.init(MP, DM, lgdim(), lbid());
        EpiRes E{Y, Y};
        pg8::gemm_phase<EpiRes, pg8::StaticOrder, true, true>(lds, g, S, E);
    }
    small_gemm(lds, HDN + (size_t)MP * DFF, Wf2T, DFF, DM, [=](int sr, int c, float v0, float v1) {
        float* y = Y + (size_t)(MP + sr) * DM + c; y[0] = ALPHA * y[0] + v0; y[1] = ALPHA * y[1] + v1; });
}
DI void ln_phase_l(int l, int which) {
    const KP pk = kargs();
    ln_phase(pk->out + O_Y, (bf16_t*)(pk->ws + WS_XB), pk->in[which ? 17 : 13] + l * DM, pk->in[which ? 18 : 14] + l * DM);
}

__global__ void __launch_bounds__(NTHR, 2) fwd(Params p_unused) {
    extern __shared__ __attribute__((aligned(16))) unsigned char lds_raw[];
    LAS unsigned char* lds = (LAS unsigned char*)lds_raw;
    cg::grid_group grid = cg::this_grid();
#ifndef PHM
#define PHM 0xff
#endif
    if (PHM & 1) prologue(lds);
    grid.sync();
#pragma unroll 1
    for (int l = 0; l < DEPTH; ++l) {
        if (PHM & 2) g1_phase(lds, l);
        grid.sync();
        if (PHM & 4) mix_phase(lds, l, l);
#ifdef PROBE_MIX2
        grid.sync(); mix_phase(lds, l, l + 2);
#endif
        grid.sync();
        if (PHM & 8) g2_phase(lds, l);
        grid.sync();
        if (PHM & 16) ln_phase_l(l, 0);
        grid.sync();
        if (PHM & 32) g3_phase(lds, l);
        grid.sync();
        if (PHM & 64) g4_phase(lds, l);
        grid.sync();
        if (PHM & 128) ln_phase_l(l, 1);
        if (l + 1 < DEPTH) grid.sync();
    }
}

extern "C" void kernel_launch(void* const* d_in, const int* in_sizes, int n_in, void* d_out, int out_size, void* d_ws, size_t ws_size, hipStream_t stream) {
    static int grid = 0;
    if (grid == 0) {
        if (n_in != 19 || ws_size < WS_END) { fprintf(stderr, "kernel_launch: unexpected n_in %d / ws %zu\n", n_in, ws_size); grid = -1; return; }
        int dev = 0, cus = 0, per_cu = 0;
        hipGetDevice(&dev); hipDeviceGetAttribute(&cus, hipDeviceAttributeMultiprocessorCount, dev);
        if (hipFuncSetAttribute((const void*)fwd, hipFuncAttributeMaxDynamicSharedMemorySize, LDS_BYTES) != hipSuccess) { fprintf(stderr, "kernel_launch: hipFuncSetAttribute failed\n"); grid = -1; return; }
        hipOccupancyMaxActiveBlocksPerMultiprocessor(&per_cu, (const void*)fwd, NTHR, LDS_BYTES);
        (void)hipGetLastError();
        if (per_cu < 1) { fprintf(stderr, "kernel_launch: occupancy query says %d\n", per_cu); per_cu = 1; }
        grid = cus;
    }
    if (grid < 0) return;
    hipMemsetAsync((char*)d_ws + WS_CTL, 0, 4096, stream);
    Params p{};
    for (int i = 0; i < 19; ++i) p.in[i] = (const float*)d_in[i];
    p.out = (float*)d_out; p.ws = (unsigned char*)d_ws;
    void* args[] = {&p};
    hipError_t e = hipLaunchCooperativeKernel((const void*)fwd, dim3(grid), dim3(NTHR), args, LDS_BYTES, stream);
    if (e != hipSuccess) fprintf(stderr, "cooperative launch failed: %s (grid %d)\n", hipGetErrorString(e), grid);
}
```
